# Optimizing an MI355X kernel written in HIP

```python
import math
import jax, jax.numpy as jnp
from jax import lax
import numpy as np

D_MODEL = 1024
BATCH = 8
SEQ = 2048
DEPTH = 1
DEC_BATCH = 128
DEC_SEQ = 4
PAST_LEN = 16384
PAGE_SIZE = 128

MIX_WIDTH = D_MODEL
W_S5 = MIX_WIDTH // 2
W_HG = MIX_WIDTH - W_S5
S5_CH = 16
S5_GROUPS = W_S5 // S5_CH
S5_STATE = 64
HG_DK = 128
HG_HEADS = W_HG // HG_DK
HG_DV = W_HG // HG_HEADS
HG_CHUNK = 64
EPS = 1e-6
LAMBDA_RE_MAX = -1e-4
PROJ_SIZES = (W_S5, W_S5, HG_HEADS * HG_DK, HG_HEADS * HG_DK, HG_HEADS * HG_DV, W_HG)
PROJ_SPLITS = tuple(int(v) for v in np.cumsum(PROJ_SIZES)[:-1])
PROJ_OUT = sum(PROJ_SIZES)

kernel_name = "hybrid_s5_hgrn2_parallel_heads_step"


def rmsnorm(x, g):
    xf = x.astype(jnp.float32)
    return xf * lax.rsqrt(jnp.mean(xf * xf, axis=-1, keepdims=True) + EPS) * g.astype(jnp.float32)


def s5_scan(bu_re, bu_im, a_re, a_im):
    ar = jnp.broadcast_to(a_re, bu_re.shape)
    ai = jnp.broadcast_to(a_im, bu_re.shape)

    def combine(e1, e2):
        ar1, ai1, br1, bi1 = e1
        ar2, ai2, br2, bi2 = e2
        return (ar2 * ar1 - ai2 * ai1, ar2 * ai1 + ai2 * ar1,
                ar2 * br1 - ai2 * bi1 + br2, ar2 * bi1 + ai2 * br1 + bi2)

    _, _, hr, hi = lax.associative_scan(combine, (ar, ai, bu_re, bu_im), axis=1)
    return hr, hi


def hgrn2_chunked(q, k, v, log_f, S0):
    Bn, L, H, DK = q.shape
    DV = v.shape[-1]
    C = HG_CHUNK if L % HG_CHUNK == 0 else L
    n = L // C

    def to_chunks(t):
        return t.reshape(Bn, n, C, H, t.shape[-1]).transpose(1, 0, 3, 2, 4)

    qc, kc, vc, gc = to_chunks(q), to_chunks(k), to_chunks(v), to_chunks(log_f)
    mask = jnp.tril(jnp.ones((C, C), dtype=bool))[:, :, None]

    def step(S, inp):
        qi, ki, vi, gi = inp
        b = jnp.cumsum(gi, axis=2)
        diff = b[:, :, :, None, :] - b[:, :, None, :, :]
        decay = jnp.exp(jnp.where(mask, diff, -jnp.inf))
        att = jnp.einsum('bhtk,bhsk,bhtsk->bhts', qi, ki, decay)
        o = jnp.einsum('bhts,bhsv->bhtv', att, vi) + jnp.einsum('bhtk,bhkv->bhtv', qi * jnp.exp(b), S)
        b_last = b[:, :, -1:, :]
        S_new = jnp.exp(b_last[:, :, 0, :])[..., None] * S + jnp.einsum('bhsk,bhsv->bhkv', ki * jnp.exp(b_last - b), vi)
        return S_new, o

    S_fin, o = lax.scan(step, S0, (qc, kc, vc, gc))
    o = o.transpose(1, 0, 3, 2, 4).reshape(Bn, L, H, DV)
    return o, S_fin


def mixer_layer(x, h0_re, h0_im, S0, norm_g, w_in, lam_re, lam_im, log_step, b_re, b_im, c_re, c_im, d,
                w_glu, b_glu, lb, onorm_g, w_out):
    Bn, L, _ = x.shape
    f32 = jnp.float32
    h = rmsnorm(x, norm_g)
    proj = h @ w_in.astype(f32)
    u, z_s, q, gf, iv, z_h = jnp.split(proj, PROJ_SPLITS, axis=-1)

    lr = jnp.minimum(lam_re.astype(f32), LAMBDA_RE_MAX)
    li = lam_im.astype(f32)
    dt = jnp.exp(log_step.astype(f32))[:, None]
    er = jnp.exp(lr * dt)
    a_re = er * jnp.cos(li * dt)
    a_im = er * jnp.sin(li * dt)
    den = lr * lr + li * li
    zr = ((a_re - 1.0) * lr + a_im * li) / den
    zi = (a_im * lr - (a_re - 1.0) * li) / den
    br, bi = b_re.astype(f32), b_im.astype(f32)
    bb_re = zr[..., None] * br - zi[..., None] * bi
    bb_im = zr[..., None] * bi + zi[..., None] * br
    ug = u.reshape(Bn, L, S5_GROUPS, S5_CH)
    bu_re = jnp.einsum('blgc,gpc->blgp', ug, bb_re)
    bu_im = jnp.einsum('blgc,gpc->blgp', ug, bb_im)
    h0r, h0i = h0_re.astype(f32), h0_im.astype(f32)
    bu_re = bu_re.at[:, 0].add(a_re * h0r - a_im * h0i)
    bu_im = bu_im.at[:, 0].add(a_re * h0i + a_im * h0r)
    hr, hi = s5_scan(bu_re, bu_im, a_re, a_im)
    y = (jnp.einsum('blgp,gcp->blgc', hr, c_re.astype(f32))
         - jnp.einsum('blgp,gcp->blgc', hi, c_im.astype(f32))
         + d.astype(f32) * ug).reshape(Bn, L, W_S5)
    g = jax.nn.gelu(y)
    s5_out = g * jax.nn.sigmoid(g @ w_glu.astype(f32) + b_glu.astype(f32)) * jax.nn.silu(z_s)

    lbf = lb.astype(f32)
    f = lbf + (1.0 - lbf) * jax.nn.sigmoid(gf)
    log_f = jnp.log(f)
    k = (1.0 - lbf) * jax.nn.sigmoid(-gf)
    qh = q.reshape(Bn, L, HG_HEADS, HG_DK)
    kh = k.reshape(Bn, L, HG_HEADS, HG_DK)
    gh = log_f.reshape(Bn, L, HG_HEADS, HG_DK)
    vh = iv.reshape(Bn, L, HG_HEADS, HG_DV)
    o, S_fin = hgrn2_chunked(qh, kh, vh, gh, S0.astype(f32))
    o = o * lax.rsqrt(jnp.mean(o * o, axis=-1, keepdims=True) + EPS)
    hg_out = o.reshape(Bn, L, W_HG) * onorm_g.astype(f32) * jax.nn.silu(z_h)

    out = jnp.concatenate([s5_out, hg_out], axis=-1) @ w_out.astype(f32)
    return x + out.astype(x.dtype), hr[:, -1], hi[:, -1], S_fin


def setup_inputs(seed: int = 0) -> dict:
    key = jax.random.key(seed)
    ks = jax.random.split(key, 24)
    f32 = jnp.float32
    n = jnp.arange(S5_STATE, dtype=f32)
    lam_re = -0.5 + 0.01 * jax.random.normal(ks[5], (DEPTH, S5_GROUPS, S5_STATE), f32)
    lam_im = math.pi * n + 0.01 * jax.random.normal(ks[6], (DEPTH, S5_GROUPS, S5_STATE), f32)
    log_step = jax.random.uniform(ks[7], (DEPTH, S5_GROUPS), f32, math.log(1e-3), math.log(1e-1))
    return {
        "x_prompt": jax.random.normal(ks[0], (BATCH, SEQ, D_MODEL), f32),
        "x_sample": jax.random.normal(ks[1], (DEC_BATCH, DEC_SEQ, D_MODEL), f32),
        "state_s5_re": 0.1 * jax.random.normal(ks[2], (DEPTH, DEC_BATCH, S5_GROUPS, S5_STATE), f32),
        "state_s5_im": 0.1 * jax.random.normal(ks[3], (DEPTH, DEC_BATCH, S5_GROUPS, S5_STATE), f32),
        "state_hgrn": 0.5 * jax.random.normal(ks[4], (DEPTH, DEC_BATCH, HG_HEADS, HG_DK, HG_DV), f32),
        "norm_g": 1.0 + 0.02 * jax.random.normal(ks[8], (DEPTH, D_MODEL), f32),
        "w_in": jax.random.normal(ks[9], (DEPTH, D_MODEL, PROJ_OUT), f32) * D_MODEL ** -0.5,
        "s5_lambda_re": lam_re,
        "s5_lambda_im": lam_im,
        "s5_log_step": log_step,
        "s5_b_re": 0.5 * jax.random.normal(ks[10], (DEPTH, S5_GROUPS, S5_STATE, S5_CH), f32),
        "s5_b_im": 0.5 * jax.random.normal(ks[11], (DEPTH, S5_GROUPS, S5_STATE, S5_CH), f32),
        "s5_c_re": jax.random.normal(ks[12], (DEPTH, S5_GROUPS, S5_CH, S5_STATE), f32) * S5_STATE ** -0.5,
        "s5_c_im": jax.random.normal(ks[13], (DEPTH, S5_GROUPS, S5_CH, S5_STATE), f32) * S5_STATE ** -0.5,
        "s5_d": 0.5 * jax.random.normal(ks[14], (DEPTH, S5_GROUPS, S5_CH), f32),
        "w_glu": jax.random.normal(ks[15], (DEPTH, W_S5, W_S5), f32) * W_S5 ** -0.5,
        "b_glu": 0.02 * jax.random.normal(ks[16], (DEPTH, W_S5), f32),
        "hgrn_lb_logits": 0.1 * jax.random.normal(ks[17], (DEPTH + 1, HG_HEADS * HG_DK), f32),
        "hgrn_onorm_g": 1.0 + 0.02 * jax.random.normal(ks[18], (DEPTH, W_HG), f32),
        "w_out": jax.random.normal(ks[19], (DEPTH, MIX_WIDTH, D_MODEL), f32) * MIX_WIDTH ** -0.5,
        "final_norm_g": 1.0 + 0.02 * jax.random.normal(ks[20], (D_MODEL,), f32),
    }


def reference(x_prompt, x_sample, state_s5_re, state_s5_im, state_hgrn, norm_g, w_in, s5_lambda_re, s5_lambda_im,
              s5_log_step, s5_b_re, s5_b_im, s5_c_re, s5_c_im, s5_d, w_glu, b_glu, hgrn_lb_logits, hgrn_onorm_g,
              w_out, final_norm_g):
    f32 = jnp.float32
    lb_all = jnp.cumsum(jax.nn.softmax(hgrn_lb_logits.astype(f32), axis=0), axis=0)
    xp, xs = x_prompt, x_sample
    zero_re = jnp.zeros((x_prompt.shape[0], S5_GROUPS, S5_STATE), f32)
    zero_S = jnp.zeros((x_prompt.shape[0], HG_HEADS, HG_DK, HG_DV), f32)
    p_re, p_im, p_hg, s_re, s_im, s_hg = [], [], [], [], [], []
    for l in range(DEPTH):
        params = (norm_g[l], w_in[l], s5_lambda_re[l], s5_lambda_im[l], s5_log_step[l], s5_b_re[l], s5_b_im[l],
                  s5_c_re[l], s5_c_im[l], s5_d[l], w_glu[l], b_glu[l], lb_all[l], hgrn_onorm_g[l], w_out[l])
        xp, hr, hi, S = mixer_layer(xp, zero_re, zero_re, zero_S, *params)
        p_re.append(hr); p_im.append(hi); p_hg.append(S)
        xs, hr, hi, S = mixer_layer(xs, state_s5_re[l], state_s5_im[l], state_hgrn[l], *params)
        s_re.append(hr); s_im.append(hi); s_hg.append(S)
    sd = state_s5_re.dtype
    y_prompt = rmsnorm(xp, final_norm_g).astype(x_prompt.dtype)
    y_sample = rmsnorm(xs, final_norm_g).astype(x_sample.dtype)
    new_s5_re_prompt = jnp.stack(p_re).astype(sd)
    new_s5_im_prompt = jnp.stack(p_im).astype(sd)
    new_hgrn_prompt = jnp.stack(p_hg).astype(state_hgrn.dtype)
    new_s5_re_sample = jnp.stack(s_re).astype(sd)
    new_s5_im_sample = jnp.stack(s_im).astype(sd)
    new_hgrn_sample = jnp.stack(s_hg).astype(state_hgrn.dtype)
    return (y_prompt, y_sample, new_s5_re_prompt, new_s5_im_prompt, new_hgrn_prompt,
            new_s5_re_sample, new_s5_im_sample, new_hgrn_sample)
```

```cpp
#include <hip/hip_runtime.h>
#include <hip/hip_cooperative_groups.h>
#include <cstdio>
namespace cg = cooperative_groups;
namespace pg8 {
#define PG8_LAS __attribute__((address_space(3)))
typedef unsigned short bf16_t;
typedef short bf16x8 __attribute__((ext_vector_type(8)));
typedef float f32x4 __attribute__((ext_vector_type(4)));
typedef unsigned u32x4 __attribute__((ext_vector_type(4)));
constexpr int BM = 256, BK = 64, HALF = 128, HTB = HALF * BK * 2  , STAGE_BYTES = 8 * HTB, NXCD = 8, WGM = 8;

__host__ __device__ __forceinline__ int lds_byte(int r, int c) { const int st = (r >> 4) * 2 + (c >> 5), rr = r & 15, cc = c & 31, ob = rr * 64 + cc * 2; return st * 1024 + (ob ^ (((ob >> 9) & 1) << 5)); }
__host__ __device__ __forceinline__ void stage_rc(int b, int& R, int& C) { const int st = b / 1024, sb = b % 1024, swz = sb ^ (((sb >> 9) & 1) << 5); R = (st >> 1) * 16 + swz / 64; C = (st & 1) * 32 + (swz % 64) / 2; }
__host__ __device__ __forceinline__ int perm32(int rho) { const int n = rho >> 4, i = rho & 15; return 8 * (i >> 2) + 4 * n + (i & 3); }

struct Unit { int pm, pn; };
struct Gemm { const bf16_t* A; const bf16_t* Bt; int M, N, K; };

struct StaticOrder {
    int nM, nN, nwg, G, c;
    __host__ __device__ void init(int M, int N, int G_, int c_) { nM = M / BM; nN = N / BM; nwg = nM * nN; G = G_; c = c_; }
    __host__ __device__ bool next(int i, Unit& u) const {
        const long L = (long)i * G + c; if (L >= nwg) return false;
        int wgid = (int)L; { const int q = nwg / NXCD, r = nwg % NXCD, xcd = wgid % NXCD, off = wgid / NXCD; wgid = (xcd < r ? xcd * (q + 1) : r * (q + 1) + (xcd - r) * q) + off; }
        const int nig = WGM * nN, gid = wgid / nig, fm = gid * WGM, gsz = (nM - fm) < WGM ? (nM - fm) : WGM;
        u.pm = fm + ((wgid % nig) % gsz); u.pn = (wgid % nig) / gsz; return true;
    }
    __device__ __forceinline__ void a_ready(const Unit&) const {}
    __device__ __forceinline__ void done(const Unit&) const {}
};
__device__ __forceinline__ unsigned cvt_pk_bf16(float lo, float hi) { unsigned r; asm volatile("v_cvt_pk_bf16_f32 %0, %1, %2" : "=v"(r) : "v"(lo), "v"(hi)); return r; }
template <class Epi, class Sched, bool STAMP = false>
__device__ __forceinline__ void gemm_phase(PG8_LAS unsigned char* lds, const Gemm g, const Sched& S, const Epi& E, unsigned long long* stamps) {
    const int tid = threadIdx.x, wid = __builtin_amdgcn_readfirstlane(tid >> 6), lane = tid & 63, wr = wid >> 2, wc = wid & 3, fr = lane & 15, fq = lane >> 4;
    const int K = g.K, nt = K / BK;
    int ts_lo = 0, ts_hi = 0, nts = 0; const unsigned long long rt_entry = STAMP ? (unsigned long long)wall_clock64() : 0ull;
#define PG8_STAMP() do { if (STAMP && wid == 0 && nts < 64) { const unsigned long long _c = (unsigned long long)clock64(); \
        ts_lo = (lane == nts) ? (int)(unsigned)_c : ts_lo; ts_hi = (lane == nts) ? (int)(unsigned)(_c >> 32) : ts_hi; ++nts; } } while (0)
    PG8_STAMP();
    unsigned voffA[2], voffB[2];
#pragma unroll
    for (int i = 0; i < 2; ++i) { int R, C; stage_rc(tid * 16 + i * 8192, R, C); const int Rb = Epi::PERM ? ((R & ~31) + perm32(R & 31)) : R;
        voffA[i] = (unsigned)(R * K + C) * 2u; voffB[i] = (unsigned)(Rb * K + C) * 2u; }
    const size_t kstep = (size_t)(BK * 2);
    const size_t hstep = (size_t)HALF * K * 2;
    const size_t tstep = 2 * hstep;
    const unsigned ldsw = (unsigned)wid * 1024u;
    const int aoff = lds_byte(wr * 64 + fr, fq * 8), boff = lds_byte(wc * 32 + fr, fq * 8);
#define PG8_SA(b, h) (((b) * 2 + (h)) * HTB)
#define PG8_SB(b, h) ((4 + (b) * 2 + (h)) * HTB)
#define PG8_STAGE(bufoff, gbase, voff) do { _Pragma("unroll") for (int _i = 0; _i < 2; ++_i) \
        __builtin_amdgcn_global_load_lds((const unsigned*)((const char*)(gbase) + (voff)[_i]), (PG8_LAS unsigned*)(lds + (bufoff) + ldsw + _i * 8192), 16, 0, 0); } while (0)
#define PG8_LDA(dst, b, h) do { _Pragma("unroll") for (int m = 0; m < 4; ++m) _Pragma("unroll") for (int k = 0; k < 2; ++k) dst[m][k] = *(const PG8_LAS bf16x8*)(lds + PG8_SA(b, h) + aoff + m * 2048 + k * 1024); } while (0)
#define PG8_LDB(dst, b, h) do { _Pragma("unroll") for (int n = 0; n < 2; ++n) _Pragma("unroll") for (int k = 0; k < 2; ++k) dst[n][k] = *(const PG8_LAS bf16x8*)(lds + PG8_SB(b, h) + boff + n * 2048 + k * 1024); } while (0)
#define PG8_MMA(ai, bj, At, Bt) do { __builtin_amdgcn_s_setprio(1); _Pragma("unroll") for (int m = 0; m < 4; ++m) _Pragma("unroll") for (int n = 0; n < 2; ++n) _Pragma("unroll") for (int k = 0; k < 2; ++k) \
        acc[ai][bj][m][n] = __builtin_amdgcn_mfma_f32_16x16x32_bf16(Bt[n][k], At[m][k], acc[ai][bj][m][n], 0, 0, 0); __builtin_amdgcn_s_setprio(0); } while (0)
#define PG8_WAIT_V(n) asm volatile("s_waitcnt vmcnt(" #n ")" ::: "memory")
#define PG8_WAIT_L(n) asm volatile("s_waitcnt lgkmcnt(" #n ")" ::: "memory")
#define PG8_BAR __builtin_amdgcn_s_barrier()
#define PG8_SCHED __builtin_amdgcn_sched_barrier(0)
    Unit cur, nxt; int ui = 0;
    if (!S.next(0, cur)) return;
    f32x4 acc[2][2][4][2];
#pragma unroll
    for (int a = 0; a < 2; ++a)
#pragma unroll
        for (int b = 0; b < 2; ++b)
#pragma unroll
            for (int m = 0; m < 4; ++m)
#pragma unroll
                for (int n = 0; n < 2; ++n) acc[a][b][m][n] = (f32x4){0.f, 0.f, 0.f, 0.f};
    bf16x8 At[4][2], B0[2][2], B1[2][2];
    const char* cA = (const char*)g.A + (size_t)cur.pm * tstep; const char* cB = (const char*)g.Bt + (size_t)cur.pn * tstep;
    S.a_ready(cur);
    PG8_STAGE(PG8_SB(0, 0), cB, voffB); PG8_STAGE(PG8_SA(0, 0), cA, voffA); PG8_STAGE(PG8_SB(0, 1), cB + hstep, voffB); PG8_STAGE(PG8_SA(0, 1), cA + hstep, voffA);
    if (wr == 1) PG8_BAR;
    PG8_WAIT_V(4); PG8_BAR;
    PG8_STAGE(PG8_SB(1, 0), cB + kstep, voffB); PG8_STAGE(PG8_SA(1, 0), cA + kstep, voffA); PG8_STAGE(PG8_SB(1, 1), cB + hstep + kstep, voffB);
    PG8_WAIT_V(6); PG8_BAR;
    PG8_STAMP();
    for (;;) {
        const bool has_next = S.next(ui + 1, nxt);
        const char* nA = has_next ? (const char*)g.A + (size_t)nxt.pm * tstep : cA; const char* nB = has_next ? (const char*)g.Bt + (size_t)nxt.pn * tstep : cB;
        for (int t = 0; t < nt; t += 2) {
            const bool last = (t == nt - 2);
            const char* a1 = cA + (size_t)(t + 1) * kstep;
            const char* a2 = last ? nA : cA + (size_t)(t + 2) * kstep; const char* b2 = last ? nB : cB + (size_t)(t + 2) * kstep;
            const char* a3 = a2 + kstep; const char* b3 = b2 + kstep;
            if (last && has_next) S.a_ready(nxt);
            PG8_LDB(B0, 0, 0); PG8_SCHED; PG8_LDA(At, 0, 0); PG8_STAGE(PG8_SA(1, 1), a1 + hstep, voffA);
            PG8_WAIT_L(8); PG8_BAR; PG8_WAIT_L(0); PG8_MMA(0, 0, At, B0); PG8_BAR; PG8_SCHED;
            PG8_LDB(B1, 0, 1); PG8_STAGE(PG8_SB(0, 0), b2, voffB);
            PG8_BAR; PG8_WAIT_L(0); PG8_MMA(0, 1, At, B1); PG8_BAR;
            PG8_LDA(At, 0, 1); PG8_STAGE(PG8_SA(0, 0), a2, voffA);
            PG8_BAR; PG8_WAIT_L(0); PG8_MMA(1, 0, At, B0); PG8_BAR; PG8_SCHED;
            PG8_STAGE(PG8_SB(0, 1), b2 + hstep, voffB);
            PG8_WAIT_V(6); PG8_BAR; PG8_MMA(1, 1, At, B1); PG8_BAR;
            PG8_LDB(B0, 1, 0); PG8_SCHED; PG8_LDA(At, 1, 0); PG8_STAGE(PG8_SA(0, 1), a2 + hstep, voffA);
            PG8_WAIT_L(8); PG8_BAR; PG8_WAIT_L(0); PG8_MMA(0, 0, At, B0); PG8_BAR; PG8_SCHED;
            PG8_LDB(B1, 1, 1); PG8_STAGE(PG8_SB(1, 0), b3, voffB);
            PG8_BAR; PG8_WAIT_L(0); PG8_MMA(0, 1, At, B1); PG8_BAR;
            PG8_LDA(At, 1, 1); PG8_STAGE(PG8_SA(1, 0), a3, voffA);
            PG8_BAR; PG8_WAIT_L(0); PG8_MMA(1, 0, At, B0); PG8_BAR; PG8_SCHED;
            PG8_STAGE(PG8_SB(1, 1), b3 + hstep, voffB);
            PG8_WAIT_V(6); PG8_BAR; PG8_MMA(1, 1, At, B1); PG8_BAR;
        }
        PG8_STAMP();
        if constexpr (!Epi::AFTER_DRAIN) { E(acc, cur, wr, wc, fr, fq); S.done(cur); }
        PG8_STAMP();
        if (!has_next) break;
#pragma unroll
        for (int a = 0; a < 2; ++a)
#pragma unroll
            for (int b = 0; b < 2; ++b)
#pragma unroll
                for (int m = 0; m < 4; ++m)
#pragma unroll
                    for (int n = 0; n < 2; ++n) acc[a][b][m][n] = (f32x4){0.f, 0.f, 0.f, 0.f};
        cur = nxt; cA = nA; cB = nB; ++ui;
    }
    PG8_WAIT_V(0);
    if (wr == 0) PG8_BAR;
    PG8_BAR;
    if constexpr (Epi::AFTER_DRAIN) { E.fused(acc, cur, wr, wc, fr, fq, lds, wid, lane); S.done(cur); }
    PG8_STAMP();
    if (STAMP && wid == 0) { stamps[lane] = lane < nts ? (((unsigned long long)(unsigned)ts_hi << 32) | (unsigned)ts_lo) : 0ull;
        if (lane == 62) stamps[62] = rt_entry; if (lane == 63) stamps[63] = (unsigned long long)wall_clock64(); }
#undef PG8_STAMP
#undef PG8_SA
#undef PG8_SB
#undef PG8_STAGE
#undef PG8_LDA
#undef PG8_LDB
#undef PG8_MMA
#undef PG8_WAIT_V
#undef PG8_WAIT_L
#undef PG8_BAR
#undef PG8_SCHED
}
}

typedef unsigned short u16;
using pg8::bf16x8; using pg8::f32x4; using pg8::u32x4;
typedef float f32x16 __attribute__((ext_vector_type(16)));
typedef short s16x4 __attribute__((ext_vector_type(4)));
#define DI __device__ __forceinline__
#define MFMA16(a, b, c) __builtin_amdgcn_mfma_f32_16x16x32_bf16((a), (b), (c), 0, 0, 0)
#define MFMA32(a, b, c) __builtin_amdgcn_mfma_f32_32x32x16_bf16((a), (b), (c), 0, 0, 0)

constexpr int NP = 16384, NTOK = 16896, NTHR = 512;
constexpr float EPSF = 1e-6f;
constexpr size_t SZT = (size_t)NTOK * 512 * 2;
constexpr size_t OFF_HB = 0;
constexpr size_t OFF_WIN = OFF_HB + (size_t)NTOK * 1024 * 2;
constexpr size_t OFF_WGLU = OFF_WIN + (size_t)3072 * 1024 * 2;
constexpr size_t OFF_WOUT = OFF_WGLU + (size_t)512 * 512 * 2;
constexpr size_t OFF_U = OFF_WOUT + (size_t)1024 * 1024 * 2;
constexpr size_t OFF_SZS = OFF_U + SZT;
constexpr size_t OFF_Q = OFF_SZS + SZT;
constexpr size_t OFF_KK = OFF_Q + SZT;
constexpr size_t OFF_V = OFF_KK + SZT;
constexpr size_t OFF_SZH = OFF_V + SZT;
constexpr size_t OFF_LF = OFF_SZH + SZT;
constexpr size_t OFF_G = OFF_LF + (size_t)NTOK * 512 * 4;
constexpr size_t OFF_CAT = OFF_G + SZT;
constexpr size_t OFF_DEC = OFF_CAT + (size_t)NTOK * 1024 * 2;
constexpr size_t OFF_HEND = OFF_DEC + (size_t)1024 * 128 * 4;
constexpr size_t OFF_HCAR = OFF_HEND + (size_t)256 * 2048 * 8;
constexpr size_t OFF_APOW = OFF_HCAR + (size_t)256 * 2048 * 8;
constexpr size_t OFF_BBR = OFF_APOW + (size_t)2048 * 65 * 8;
constexpr size_t OFF_BBI = OFF_BBR + (size_t)2048 * 16 * 2;
constexpr size_t OFF_CMT = OFF_BBI + (size_t)2048 * 16 * 2;
constexpr size_t OFF_LB = OFF_CMT + (size_t)32 * 16 * 128 * 2;
constexpr size_t OFF_SSQ = OFF_LB + 2048;
constexpr size_t WS_END = OFF_SSQ + (size_t)NTOK * 4;
constexpr size_t O_Y = 0, O_PRE = 17301504, O_PIM = 17317888, O_PHG = 17334272, O_SRE = 17858560, O_SIM = 18120704, O_SHG = 18382848;
constexpr int LDS_BYTES = 131072;

struct Params { const float* in[21]; float* out; unsigned char* ws; };

DI u16 f2bf(float f) { unsigned u = __float_as_uint(f); u += 0x7FFFu + ((u >> 16) & 1u); return (u16)(u >> 16); }
DI float bf2f(u16 h) { return __uint_as_float((unsigned)h << 16); }
DI unsigned pk2(float lo, float hi) { return (unsigned)f2bf(lo) | ((unsigned)f2bf(hi) << 16); }
DI float wave_sum(float v) {
#pragma unroll
    for (int o = 32; o > 0; o >>= 1) v += __shfl_xor(v, o);
    return v;
}
DI float sigmoidf_(float x) { return 1.0f / (1.0f + __expf(-x)); }
DI float siluf_(float x) { return x / (1.0f + __expf(-x)); }
DI float geluf_(float x) { const float u = 0.7978845608f * (x + 0.044715f * x * x * x); return x / (1.0f + __expf(-2.0f * u)); }
DI void wave_lds_sync() { __builtin_amdgcn_fence(__ATOMIC_RELEASE, "wavefront"); asm volatile("s_waitcnt lgkmcnt(0)" ::: "memory"); __builtin_amdgcn_wave_barrier(); __builtin_amdgcn_fence(__ATOMIC_ACQUIRE, "wavefront"); }

DI void transpose_tile(const float* __restrict__ W, int K, int N, u16* __restrict__ Wt, int tk, int tn, float* tile) {
    const int t = threadIdx.x, k0 = tk * 64, n0 = tn * 64;
    { const int kk = t >> 3, c8 = (t & 7) * 8; const float* src = W + (size_t)(k0 + kk) * N + n0 + c8;
      const float4 a = *(const float4*)src, b = *(const float4*)(src + 4);
      float* d = tile + kk * 65 + c8; d[0] = a.x; d[1] = a.y; d[2] = a.z; d[3] = a.w; d[4] = b.x; d[5] = b.y; d[6] = b.z; d[7] = b.w; }
    __syncthreads();
    { const int n = t >> 3, k8 = (t & 7) * 8; float v[8];
#pragma unroll
      for (int j = 0; j < 8; ++j) v[j] = tile[(k8 + j) * 65 + n];
      u32x4 w; w.x = pk2(v[0], v[1]); w.y = pk2(v[2], v[3]); w.z = pk2(v[4], v[5]); w.w = pk2(v[6], v[7]);
      *(u32x4*)(Wt + (size_t)(n0 + n) * K + k0 + k8) = w; }
    __syncthreads();
}

DI void phase_prep(const Params& P, unsigned char* lds) {
    unsigned char* ws = P.ws;
    const int tid = threadIdx.x, lane = tid & 63, wid = tid >> 6;
    { u16* HB = (u16*)(ws + OFF_HB); const float* ng = P.in[5];
      const int gw = blockIdx.x * 8 + wid, nw = gridDim.x * 8;
      for (int r = gw; r < NTOK; r += nw) {
          const float* xr = (r < NP) ? P.in[0] + (size_t)r * 1024 : P.in[1] + (size_t)(r - NP) * 1024;
          float4 v[4]; float ss = 0.f;
#pragma unroll
          for (int i = 0; i < 4; ++i) { v[i] = *(const float4*)(xr + i * 256 + lane * 4); ss += v[i].x * v[i].x + v[i].y * v[i].y + v[i].z * v[i].z + v[i].w * v[i].w; }
          ss = wave_sum(ss);
          const float rstd = rsqrtf(ss * (1.0f / 1024.0f) + EPSF);
#pragma unroll
          for (int i = 0; i < 4; ++i) { const float4 g4 = *(const float4*)(ng + i * 256 + lane * 4);
              uint2 w; w.x = pk2(v[i].x * rstd * g4.x, v[i].y * rstd * g4.y); w.y = pk2(v[i].z * rstd * g4.z, v[i].w * rstd * g4.w);
              *(uint2*)(HB + (size_t)r * 1024 + i * 256 + lane * 4) = w; }
      } }
    { float* tile = (float*)lds;
      for (int item = blockIdx.x; item < 1088; item += gridDim.x) {
          if (item < 768) transpose_tile(P.in[6], 1024, 3072, (u16*)(ws + OFF_WIN), item & 15, item >> 4, tile);
          else if (item < 832) { const int i2 = item - 768; transpose_tile(P.in[15], 512, 512, (u16*)(ws + OFF_WGLU), i2 & 7, i2 >> 3, tile); }
          else { const int i2 = item - 832; transpose_tile(P.in[19], 1024, 1024, (u16*)(ws + OFF_WOUT), i2 & 15, i2 >> 4, tile); }
      } }
    { const int gt = blockIdx.x * NTHR + tid, ngt = gridDim.x * NTHR;
      for (int i = gt; i < 2048; i += ngt) {
          const int g = i >> 6;
          const double lr = fmin((double)P.in[7][i], -1e-4), li = (double)P.in[8][i], dt = exp((double)P.in[9][g]);
          float2* ap = (float2*)(ws + OFF_APOW) + (size_t)i * 65;
          const double th = li * dt, lg = lr * dt;
          double are = 0.0, aim = 0.0;
          for (int j = 0; j <= 64; ++j) {
              const double x = th * (double)j; const double n = rint(x * 0.15915494309189535); const double r = x - n * 6.283185307179586;
              const double m = exp(lg * (double)j); const double cr = cos(r), sr = sin(r);
              ap[j] = make_float2((float)(m * cr), (float)(m * sr));
              if (j == 1) { are = m * cr; aim = m * sr; }
          }
          const double den = lr * lr + li * li;
          const double zr = ((are - 1.0) * lr + aim * li) / den, zi = (aim * lr - (are - 1.0) * li) / den;
          u16* bbr = (u16*)(ws + OFF_BBR) + (size_t)i * 16; u16* bbi = (u16*)(ws + OFF_BBI) + (size_t)i * 16;
          const int p = i & 63;
          for (int c = 0; c < 16; ++c) { const double br = (double)P.in[10][(size_t)i * 16 + c], bi = (double)P.in[11][(size_t)i * 16 + c];
              bbr[c] = f2bf((float)(zr * br - zi * bi)); bbi[c] = f2bf((float)(zr * bi + zi * br)); }
          u16* cm = (u16*)(ws + OFF_CMT) + (size_t)g * 16 * 128;
          for (int c = 0; c < 16; ++c) { cm[c * 128 + 2 * p] = f2bf(P.in[12][((size_t)g * 16 + c) * 64 + p]); cm[c * 128 + 2 * p + 1] = f2bf(-P.in[13][((size_t)g * 16 + c) * 64 + p]); }
      }
      for (int i = gt; i < 512; i += ngt) { const float l0 = P.in[17][i], l1 = P.in[17][512 + i]; ((float*)(ws + OFF_LB))[i] = 1.0f / (1.0f + expf(l1 - l0)); }
      for (int i = gt; i < NTOK; i += ngt) ((float*)(ws + OFF_SSQ))[i] = 0.f;
    }
}

struct EpiProj {
    static constexpr bool PERM = true, AFTER_DRAIN = false;
    unsigned char* ws;
    DI void operator()(const f32x4 (&acc)[2][2][4][2], const pg8::Unit& u, int wr, int wc, int fr, int fq) const {
        const int type = u.pn >> 1;
        const int cbase = (u.pn & 1) * 256 + wc * 32 + 8 * fq;
        const int row0 = u.pm * 256 + wr * 64 + fr;
        if (type == 3) {
            const float* LB = (const float*)(ws + OFF_LB); float* LF = (float*)(ws + OFF_LF); u16* KK = (u16*)(ws + OFF_KK);
#pragma unroll
            for (int bj = 0; bj < 2; ++bj) {
                const int col = cbase + bj * 128;
                const f32x4 lb0 = *(const f32x4*)(LB + col), lb1 = *(const f32x4*)(LB + col + 4);
#pragma unroll
                for (int ai = 0; ai < 2; ++ai)
#pragma unroll
                    for (int m = 0; m < 4; ++m) {
                        const size_t row = (size_t)(row0 + ai * 128 + m * 16);
                        f32x4 lf0, lf1; float kv[8];
#pragma unroll
                        for (int j = 0; j < 8; ++j) {
                            float x = (j < 4) ? acc[ai][bj][m][0][j & 3] : acc[ai][bj][m][1][j & 3];
                            const float lb = (j < 4) ? lb0[j & 3] : lb1[j & 3];
                            x = fminf(fmaxf(x, -30.f), 30.f);
                            const float e = __expf(-x), sg = 1.0f / (1.0f + e);
                            const float f = lb + (1.0f - lb) * sg;
                            const float l = __logf(f);
                            if (j < 4) lf0[j & 3] = l; else lf1[j & 3] = l;
                            kv[j] = (1.0f - lb) * e * sg;
                        }
                        *(f32x4*)(LF + row * 512 + col) = lf0; *(f32x4*)(LF + row * 512 + col + 4) = lf1;
                        u32x4 w; w.x = pk2(kv[0], kv[1]); w.y = pk2(kv[2], kv[3]); w.z = pk2(kv[4], kv[5]); w.w = pk2(kv[6], kv[7]);
                        *(u32x4*)(KK + row * 512 + col) = w;
                    }
            }
        } else {
            const bool act = (type == 1) || (type == 5);
            u16* O = (u16*)(ws + (type == 0 ? OFF_U : type == 1 ? OFF_SZS : type == 2 ? OFF_Q : type == 4 ? OFF_V : OFF_SZH));
#pragma unroll
            for (int ai = 0; ai < 2; ++ai)
#pragma unroll
                for (int m = 0; m < 4; ++m) {
                    const size_t row = (size_t)(row0 + ai * 128 + m * 16);
#pragma unroll
                    for (int bj = 0; bj < 2; ++bj) {
                        f32x4 v0 = acc[ai][bj][m][0], v1 = acc[ai][bj][m][1];
                        if (act) {
#pragma unroll
                            for (int j = 0; j < 4; ++j) { v0[j] = siluf_(v0[j]); v1[j] = siluf_(v1[j]); }
                        }
                        u32x4 w; w.x = pk2(v0[0], v0[1]); w.y = pk2(v0[2], v0[3]); w.z = pk2(v1[0], v1[1]); w.w = pk2(v1[2], v1[3]);
                        *(u32x4*)(O + row * 512 + cbase + bj * 128) = w;
                    }
                }
        }
    }
};

struct EpiGlu {
    static constexpr bool PERM = true, AFTER_DRAIN = false;
    unsigned char* ws; const float* bglu;
    DI void operator()(const f32x4 (&acc)[2][2][4][2], const pg8::Unit& u, int wr, int wc, int fr, int fq) const {
        const u16* G = (const u16*)(ws + OFF_G); const u16* SZS = (const u16*)(ws + OFF_SZS); u16* CAT = (u16*)(ws + OFF_CAT);
        const int cbase = u.pn * 256 + wc * 32 + 8 * fq;
        const int row0 = u.pm * 256 + wr * 64 + fr;
#pragma unroll
        for (int bj = 0; bj < 2; ++bj) {
            const int col = cbase + bj * 128;
            const f32x4 b0 = *(const f32x4*)(bglu + col), b1 = *(const f32x4*)(bglu + col + 4);
#pragma unroll
            for (int ai = 0; ai < 2; ++ai)
#pragma unroll
                for (int m = 0; m < 4; ++m) {
                    const size_t row = (size_t)(row0 + ai * 128 + m * 16);
                    const u32x4 g8 = *(const u32x4*)(G + row * 512 + col), z8 = *(const u32x4*)(SZS + row * 512 + col);
                    float o[8];
#pragma unroll
                    for (int j = 0; j < 8; ++j) {
                        const float a = ((j < 4) ? acc[ai][bj][m][0][j & 3] : acc[ai][bj][m][1][j & 3]) + ((j < 4) ? b0[j & 3] : b1[j & 3]);
                        const unsigned gw = g8[j >> 1], zw = z8[j >> 1];
                        const float gv = (j & 1) ? __uint_as_float(gw & 0xffff0000u) : __uint_as_float(gw << 16);
                        const float zv = (j & 1) ? __uint_as_float(zw & 0xffff0000u) : __uint_as_float(zw << 16);
                        o[j] = gv * sigmoidf_(a) * zv;
                    }
                    u32x4 w; w.x = pk2(o[0], o[1]); w.y = pk2(o[2], o[3]); w.z = pk2(o[4], o[5]); w.w = pk2(o[6], o[7]);
                    *(u32x4*)(CAT + row * 1024 + col) = w;
                }
        }
    }
};

struct EpiOut {
    static constexpr bool PERM = false, AFTER_DRAIN = false;
    const float* xp; const float* xs; float* out; float* ssq;
    DI void operator()(const f32x4 (&acc)[2][2][4][2], const pg8::Unit& u, int wr, int wc, int fr, int fq) const {
        const int row0 = u.pm * 256 + wr * 64 + fr, col0 = u.pn * 256 + wc * 32 + 4 * fq;
#pragma unroll
        for (int ai = 0; ai < 2; ++ai)
#pragma unroll
            for (int m = 0; m < 4; ++m) {
                const int row = row0 + ai * 128 + m * 16;
                const float* xr = (row < NP) ? xp + (size_t)row * 1024 : xs + (size_t)(row - NP) * 1024;
                float* orow = out + (size_t)row * 1024;
                float ss = 0.f;
#pragma unroll
                for (int bj = 0; bj < 2; ++bj)
#pragma unroll
                    for (int n = 0; n < 2; ++n) {
                        const int col = col0 + bj * 128 + n * 16;
                        const f32x4 xv = *(const f32x4*)(xr + col);
                        const f32x4 r = acc[ai][bj][m][n] + xv;
                        *(f32x4*)(orow + col) = r;
                        ss += r[0] * r[0] + r[1] * r[1] + r[2] * r[2] + r[3] * r[3];
                    }
                ss += __shfl_xor(ss, 16); ss += __shfl_xor(ss, 32);
                if (fq == 0) atomicAdd(ssq + row, ss);
            }
    }
};

DI void s5_pass1(const Params& P) {
    unsigned char* ws = P.ws;
    const int tid = threadIdx.x, lane = tid & 63, wid = tid >> 6, gw = blockIdx.x * 8 + wid, nw = gridDim.x * 8;
    const int n = lane & 31, h = lane >> 5;
    const u16* U = (const u16*)(ws + OFF_U); const u16* BBR = (const u16*)(ws + OFF_BBR); const u16* BBI = (const u16*)(ws + OFF_BBI);
    const float2* APOW = (const float2*)(ws + OFF_APOW); float2* HEND = (float2*)(ws + OFF_HEND);
    for (int T = gw; T < 16384; T += nw) {
        const int gh = T & 63, bc = T >> 6, g = gh >> 1, half = gh & 1, p = half * 32 + n;
        const int tok0 = (bc >> 5) * 2048 + (bc & 31) * 64;
        const bf16x8 bre = *(const bf16x8*)(BBR + (size_t)(g * 64 + p) * 16 + 8 * h), bim = *(const bf16x8*)(BBI + (size_t)(g * 64 + p) * 16 + 8 * h);
        f32x16 z; for (int i = 0; i < 16; ++i) z[i] = 0.f;
        const bf16x8 a0 = *(const bf16x8*)(U + (size_t)(tok0 + n) * 512 + g * 16 + 8 * h);
        const bf16x8 a1 = *(const bf16x8*)(U + (size_t)(tok0 + 32 + n) * 512 + g * 16 + 8 * h);
        const f32x16 cr0 = MFMA32(a0, bre, z), ci0 = MFMA32(a0, bim, z), cr1 = MFMA32(a1, bre, z), ci1 = MFMA32(a1, bim, z);
        const float2* ap = APOW + (size_t)(g * 64 + p) * 65;
        float e0r = 0.f, e0i = 0.f, e1r = 0.f, e1i = 0.f;
#pragma unroll
        for (int i = 0; i < 16; ++i) {
            const int crow = (i & 3) + 8 * (i >> 2) + 4 * h;
            const float2 w = ap[31 - crow];
            e1r += w.x * cr1[i] - w.y * ci1[i]; e1i += w.x * ci1[i] + w.y * cr1[i];
            e0r += w.x * cr0[i] - w.y * ci0[i]; e0i += w.x * ci0[i] + w.y * cr0[i];
        }
        const float2 a32 = ap[32];
        float tr = e1r + a32.x * e0r - a32.y * e0i, ti = e1i + a32.x * e0i + a32.y * e0r;
        tr += __shfl_xor(tr, 32); ti += __shfl_xor(ti, 32);
        if (h == 0) HEND[(size_t)bc * 2048 + g * 64 + p] = make_float2(tr, ti);
    }
}

DI void s5_sample(const Params& P, unsigned char* lds) {
    unsigned char* ws = P.ws;
    const int tid = threadIdx.x, lane = tid & 63, wid = tid >> 6, gw = blockIdx.x * 8 + wid, nw = gridDim.x * 8;
    float* Hw = (float*)lds + wid * 512;
    const u16* U = (const u16*)(ws + OFF_U); const u16* BBR = (const u16*)(ws + OFF_BBR); const u16* BBI = (const u16*)(ws + OFF_BBI);
    const float2* APOW = (const float2*)(ws + OFF_APOW); u16* G = (u16*)(ws + OFF_G);
    const int c = lane & 15, qd = lane >> 4;
    for (int T = gw; T < 4096; T += nw) {
        const int bs = T >> 5, g = T & 31, p = lane;
        const float2 A = APOW[(size_t)(g * 64 + p) * 65 + 1];
        float hr = P.in[2][(size_t)(bs * 32 + g) * 64 + p], hi = P.in[3][(size_t)(bs * 32 + g) * 64 + p];
        const u32x4 br0 = *(const u32x4*)(BBR + (size_t)(g * 64 + p) * 16), br1 = *(const u32x4*)(BBR + (size_t)(g * 64 + p) * 16 + 8);
        const u32x4 bi0 = *(const u32x4*)(BBI + (size_t)(g * 64 + p) * 16), bi1 = *(const u32x4*)(BBI + (size_t)(g * 64 + p) * 16 + 8);
#pragma unroll
        for (int t = 0; t < 4; ++t) {
            const u16* ur = U + (size_t)(NP + bs * 4 + t) * 512 + g * 16;
            const u32x4 u0 = *(const u32x4*)ur, u1 = *(const u32x4*)(ur + 8);
            float bur = 0.f, bui = 0.f;
#pragma unroll
            for (int k = 0; k < 8; ++k) {
                const unsigned uw = (k < 4) ? u0[k & 3] : u1[k & 3];
                const unsigned rw = (k < 4) ? br0[k & 3] : br1[k & 3];
                const unsigned iw = (k < 4) ? bi0[k & 3] : bi1[k & 3];
                const float ul = __uint_as_float(uw << 16), uh = __uint_as_float(uw & 0xffff0000u);
                bur += __uint_as_float(rw << 16) * ul + __uint_as_float(rw & 0xffff0000u) * uh;
                bui += __uint_as_float(iw << 16) * ul + __uint_as_float(iw & 0xffff0000u) * uh;
            }
            const float nr = A.x * hr - A.y * hi + bur, ni = A.x * hi + A.y * hr + bui;
            hr = nr; hi = ni;
            Hw[t * 128 + p] = hr; Hw[t * 128 + 64 + p] = hi;
        }
        P.out[O_SRE + (size_t)(bs * 32 + g) * 64 + p] = hr; P.out[O_SIM + (size_t)(bs * 32 + g) * 64 + p] = hi;
        wave_lds_sync();
        const float* cre = P.in[12] + ((size_t)g * 16 + c) * 64 + qd * 16; const float* cim = P.in[13] + ((size_t)g * 16 + c) * 64 + qd * 16;
        const float dd = P.in[14][g * 16 + c];
#pragma unroll
        for (int t = 0; t < 4; ++t) {
            float a = 0.f;
#pragma unroll
            for (int i = 0; i < 16; ++i) a += cre[i] * Hw[t * 128 + qd * 16 + i] - cim[i] * Hw[t * 128 + 64 + qd * 16 + i];
            a += __shfl_xor(a, 16); a += __shfl_xor(a, 32);
            const size_t tok = (size_t)(NP + bs * 4 + t);
            const float y = a + dd * bf2f(U[tok * 512 + g * 16 + c]);
            if (qd == 0) G[tok * 512 + g * 16 + c] = f2bf(geluf_(y));
        }
        wave_lds_sync();
    }
}

template <bool PASS2>
DI void hgrn_unit(const Params& P, unsigned char* lds, int unit) {
    unsigned char* ws = P.ws;
    const int tid = threadIdx.x, lane = tid & 63, wid = tid >> 6, fr = lane & 15, fq = lane >> 4;
    const int b = unit >> 7, hh = (unit >> 5) & 3, chunk = unit & 31;
    const int tokc = b * 2048 + chunk * 64;
    u16* Qt = (u16*)lds;
    u16* Kt = PASS2 ? (u16*)(lds + 17408) : (u16*)lds;
    u16* VT = (u16*)(lds + 34816);
    float* SEG = (float*)(lds + 53248);
    float* SS = (float*)(lds + 55296);
    const u16* Qg = (const u16*)(ws + OFF_Q); const u16* Kg = (const u16*)(ws + OFF_KK); const u16* Vg = (const u16*)(ws + OFF_V); const float* LFg = (const float*)(ws + OFF_LF);
    {
        const int col = tid & 127, seg = tid >> 7;
        const size_t base = (size_t)(tokc + seg * 16) * 512 + hh * 128 + col;
        float c[16]; u16 kk[16], vv[16], qq[16];
#pragma unroll
        for (int i = 0; i < 16; ++i) { c[i] = LFg[base + (size_t)i * 512]; kk[i] = Kg[base + (size_t)i * 512]; vv[i] = Vg[base + (size_t)i * 512]; if (PASS2) qq[i] = Qg[base + (size_t)i * 512]; }
#pragma unroll
        for (int i = 1; i < 16; ++i) c[i] += c[i - 1];
        SEG[seg * 128 + col] = c[15];
        __syncthreads();
        float pre = 0.f, tot = 0.f;
#pragma unroll
        for (int s = 0; s < 4; ++s) { const float v = SEG[s * 128 + col]; tot += v; if (s < seg) pre += v; }
        u32x4 v0, v1;
        v0.x = (unsigned)vv[0] | ((unsigned)vv[1] << 16); v0.y = (unsigned)vv[2] | ((unsigned)vv[3] << 16); v0.z = (unsigned)vv[4] | ((unsigned)vv[5] << 16); v0.w = (unsigned)vv[6] | ((unsigned)vv[7] << 16);
        v1.x = (unsigned)vv[8] | ((unsigned)vv[9] << 16); v1.y = (unsigned)vv[10] | ((unsigned)vv[11] << 16); v1.z = (unsigned)vv[12] | ((unsigned)vv[13] << 16); v1.w = (unsigned)vv[14] | ((unsigned)vv[15] << 16);
        *(u32x4*)(VT + col * 72 + seg * 16) = v0; *(u32x4*)(VT + col * 72 + seg * 16 + 8) = v1;
        if (PASS2) {
#pragma unroll
            for (int i = 0; i < 16; ++i) {
                const float bb = pre + c[i];
                Qt[(seg * 16 + i) * 136 + col] = f2bf(bf2f(qq[i]) * __expf(bb));
                Kt[(seg * 16 + i) * 136 + col] = f2bf(bf2f(kk[i]) * __expf(-bb));
            }
        } else {
            float kh[16];
#pragma unroll
            for (int i = 0; i < 16; ++i) kh[i] = bf2f(kk[i]) * __expf(tot - (pre + c[i]));
            u32x4 k0, k1;
            k0.x = pk2(kh[0], kh[1]); k0.y = pk2(kh[2], kh[3]); k0.z = pk2(kh[4], kh[5]); k0.w = pk2(kh[6], kh[7]);
            k1.x = pk2(kh[8], kh[9]); k1.y = pk2(kh[10], kh[11]); k1.z = pk2(kh[12], kh[13]); k1.w = pk2(kh[14], kh[15]);
            *(u32x4*)(Kt + col * 72 + seg * 16) = k0; *(u32x4*)(Kt + col * 72 + seg * 16 + 8) = k1;
            if (seg == 0) ((float*)(ws + OFF_DEC))[(size_t)unit * 128 + col] = __expf(tot);
        }
        __syncthreads();
    }
    if (!PASS2) {
        float* SLOC = P.out + O_Y + (size_t)unit * 16384;
        const int kt = wid;
        const bf16x8 a0 = *(const bf16x8*)(Kt + (kt * 16 + fr) * 72 + fq * 8), a1 = *(const bf16x8*)(Kt + (kt * 16 + fr) * 72 + 32 + fq * 8);
#pragma unroll
        for (int vt = 0; vt < 8; ++vt) {
            f32x4 acc = {0.f, 0.f, 0.f, 0.f};
            const bf16x8 b0 = *(const bf16x8*)(VT + (vt * 16 + fr) * 72 + fq * 8), b1 = *(const bf16x8*)(VT + (vt * 16 + fr) * 72 + 32 + fq * 8);
            acc = MFMA16(a0, b0, acc); acc = MFMA16(a1, b1, acc);
            *(f32x4*)(SLOC + (size_t)(vt * 16 + fr) * 128 + kt * 16 + 4 * fq) = acc;
        }
    } else {
        const u16* SST = (const u16*)(ws + OFF_HB) + (size_t)unit * 16384;
        const int tt = wid & 3, vh = wid >> 2;
        bf16x8 bq[4];
#pragma unroll
        for (int ks = 0; ks < 4; ++ks) bq[ks] = *(const bf16x8*)(Qt + (tt * 16 + fr) * 136 + ks * 32 + fq * 8);
        float pv[4][4];
#pragma unroll
        for (int st = 0; st < 4; ++st) {
            f32x4 pa = {0.f, 0.f, 0.f, 0.f};
#pragma unroll
            for (int ks = 0; ks < 4; ++ks) { const bf16x8 ak = *(const bf16x8*)(Kt + (st * 16 + fr) * 136 + ks * 32 + fq * 8); pa = MFMA16(ak, bq[ks], pa); }
#pragma unroll
            for (int j = 0; j < 4; ++j) pv[st][j] = ((st * 16 + 4 * fq + j) <= (tt * 16 + fr)) ? pa[j] : 0.f;
        }
        bf16x8 pf[2];
#pragma unroll
        for (int k2 = 0; k2 < 2; ++k2) {
            u32x4 w; w.x = pk2(pv[2 * k2][0], pv[2 * k2][1]); w.y = pk2(pv[2 * k2][2], pv[2 * k2][3]); w.z = pk2(pv[2 * k2 + 1][0], pv[2 * k2 + 1][1]); w.w = pk2(pv[2 * k2 + 1][2], pv[2 * k2 + 1][3]);
            pf[k2] = __builtin_bit_cast(bf16x8, w);
        }
        f32x4 oacc[4]; float ssq = 0.f;
#pragma unroll
        for (int vl = 0; vl < 4; ++vl) {
            const int vt = vh * 4 + vl;
            f32x4 o = {0.f, 0.f, 0.f, 0.f};
#pragma unroll
            for (int k2 = 0; k2 < 2; ++k2) {
                const s16x4 lo = *(const s16x4*)(VT + (vt * 16 + fr) * 72 + 32 * k2 + 4 * fq), hi = *(const s16x4*)(VT + (vt * 16 + fr) * 72 + 32 * k2 + 16 + 4 * fq);
                const bf16x8 av = __builtin_shufflevector(lo, hi, 0, 1, 2, 3, 4, 5, 6, 7);
                o = MFMA16(av, pf[k2], o);
            }
#pragma unroll
            for (int ks = 0; ks < 4; ++ks) { const bf16x8 as = *(const bf16x8*)(SST + (size_t)(vt * 16 + fr) * 128 + ks * 32 + fq * 8); o = MFMA16(as, bq[ks], o); }
            oacc[vl] = o; ssq += o[0] * o[0] + o[1] * o[1] + o[2] * o[2] + o[3] * o[3];
        }
        ssq += __shfl_xor(ssq, 16); ssq += __shfl_xor(ssq, 32);
        if (fq == 0) SS[vh * 64 + tt * 16 + fr] = ssq;
        __syncthreads();
        const float rstd = rsqrtf((SS[tt * 16 + fr] + SS[64 + tt * 16 + fr]) * (1.0f / 128.0f) + EPSF);
        const size_t tok = (size_t)(tokc + tt * 16 + fr);
        const u16* SZH = (const u16*)(ws + OFF_SZH); u16* CAT = (u16*)(ws + OFF_CAT); const float* og = P.in[18];
#pragma unroll
        for (int vl = 0; vl < 4; ++vl) {
            const int v0 = hh * 128 + (vh * 4 + vl) * 16 + 4 * fq;
            const f32x4 g4 = *(const f32x4*)(og + v0);
            const uint2 z = *(const uint2*)(SZH + tok * 512 + v0);
            uint2 w;
            w.x = pk2(oacc[vl][0] * rstd * g4[0] * __uint_as_float(z.x << 16), oacc[vl][1] * rstd * g4[1] * __uint_as_float(z.x & 0xffff0000u));
            w.y = pk2(oacc[vl][2] * rstd * g4[2] * __uint_as_float(z.y << 16), oacc[vl][3] * rstd * g4[3] * __uint_as_float(z.y & 0xffff0000u));
            *(uint2*)(CAT + tok * 1024 + 512 + v0) = w;
        }
    }
    __syncthreads();
}

DI void hgrn_sample(const Params& P, unsigned char* lds, int task) {
    unsigned char* ws = P.ws;
    const int tid = threadIdx.x, lane = tid & 63, wid = tid >> 6;
    const int bs = task >> 2, hh = task & 3;
    float* QE = (float*)lds;
    float* KH = QE + 512;
    float* EB3 = KH + 512;
    float* VV = EB3 + 128;
    float* RED = VV + 512;
    float* RED2 = RED + 32;
    float* OP = RED2 + 32;
    const size_t tokb = (size_t)(NP + bs * 4);
    if (tid < 128) {
        const int k = tid; float lf[4], q[4], kk[4], bb[4];
#pragma unroll
        for (int t = 0; t < 4; ++t) { const size_t o = (tokb + t) * 512 + hh * 128 + k; lf[t] = ((const float*)(ws + OFF_LF))[o]; q[t] = bf2f(((const u16*)(ws + OFF_Q))[o]); kk[t] = bf2f(((const u16*)(ws + OFF_KK))[o]); }
        bb[0] = lf[0]; bb[1] = bb[0] + lf[1]; bb[2] = bb[1] + lf[2]; bb[3] = bb[2] + lf[3];
#pragma unroll
        for (int t = 0; t < 4; ++t) { QE[t * 128 + k] = q[t] * __expf(bb[t]); KH[t * 128 + k] = kk[t] * __expf(bb[3] - bb[t]); }
        EB3[k] = __expf(bb[3]);
        int idx = 0;
#pragma unroll
        for (int t = 0; t < 4; ++t)
#pragma unroll
            for (int s = 0; s <= t; ++s) { float pr = q[t] * kk[s] * __expf(bb[t] - bb[s]); pr = wave_sum(pr); if (lane == 0) RED[wid * 16 + idx] = pr; ++idx; }
    } else if (tid < 256) {
        const int v = tid - 128;
#pragma unroll
        for (int s = 0; s < 4; ++s) VV[s * 128 + v] = bf2f(((const u16*)(ws + OFF_V))[(tokb + s) * 512 + hh * 128 + v]);
    }
    __syncthreads();
    {
        const int v4 = tid & 31, kg = tid >> 5;
        const float* S0 = P.in[4] + (size_t)(bs * 4 + hh) * 16384; float* SN = P.out + O_SHG + (size_t)(bs * 4 + hh) * 16384;
        f32x4 op[4]; for (int t = 0; t < 4; ++t) op[t] = (f32x4){0.f, 0.f, 0.f, 0.f};
        f32x4 vs[4]; for (int s = 0; s < 4; ++s) vs[s] = *(const f32x4*)(VV + s * 128 + 4 * v4);
#pragma unroll
        for (int i = 0; i < 8; ++i) {
            const int k = kg * 8 + i;
            const f32x4 s4 = *(const f32x4*)(S0 + (size_t)k * 128 + 4 * v4);
            f32x4 sn = s4 * EB3[k];
#pragma unroll
            for (int t = 0; t < 4; ++t) { op[t] += s4 * QE[t * 128 + k]; sn += vs[t] * KH[t * 128 + k]; }
            *(f32x4*)(SN + (size_t)k * 128 + 4 * v4) = sn;
        }
#pragma unroll
        for (int t = 0; t < 4; ++t) *(f32x4*)(OP + (kg * 4 + t) * 128 + 4 * v4) = op[t];
    }
    __syncthreads();
    {
        const int t = tid >> 7, v = tid & 127;
        float o = 0.f;
#pragma unroll
        for (int kg = 0; kg < 16; ++kg) o += OP[(kg * 4 + t) * 128 + v];
        const int tb = (t * (t + 1)) >> 1;
        for (int s = 0; s <= t; ++s) o += (RED[tb + s] + RED[16 + tb + s]) * VV[s * 128 + v];
        const float ss = wave_sum(o * o);
        if (lane == 0) RED2[wid] = ss;
        __syncthreads();
        const float rstd = rsqrtf((RED2[2 * t] + RED2[2 * t + 1]) * (1.0f / 128.0f) + EPSF);
        const size_t tok = tokb + t;
        const float z = bf2f(((const u16*)(ws + OFF_SZH))[tok * 512 + hh * 128 + v]);
        ((u16*)(ws + OFF_CAT))[tok * 1024 + 512 + hh * 128 + v] = f2bf(o * rstd * P.in[18][hh * 128 + v] * z);
    }
    __syncthreads();
}

DI void phase_scan(const Params& P) {
    unsigned char* ws = P.ws;
    const int gt = blockIdx.x * NTHR + threadIdx.x, ngt = gridDim.x * NTHR;
    { const float* SLOC = P.out + O_Y; const float* DEC = (const float*)(ws + OFF_DEC); u16* SST = (u16*)(ws + OFF_HB);
      for (int idx = gt; idx < 131072; idx += ngt) {
          const int bh = idx >> 12, rem = idx & 4095, v = rem >> 5, k4 = rem & 31;
          f32x4 S = {0.f, 0.f, 0.f, 0.f};
          for (int c = 0; c < 32; ++c) {
              const size_t unit = (size_t)bh * 32 + c;
              const f32x4 sl = *(const f32x4*)(SLOC + (unit * 128 + v) * 128 + 4 * k4);
              const f32x4 d = *(const f32x4*)(DEC + unit * 128 + 4 * k4);
              uint2 w; w.x = pk2(S[0], S[1]); w.y = pk2(S[2], S[3]);
              *(uint2*)(SST + (unit * 128 + v) * 128 + 4 * k4) = w;
              S = d * S + sl;
          }
#pragma unroll
          for (int j = 0; j < 4; ++j) P.out[O_PHG + ((size_t)bh * 128 + 4 * k4 + j) * 128 + v] = S[j];
      } }
    { const float2* HEND = (const float2*)(ws + OFF_HEND); float2* HCAR = (float2*)(ws + OFF_HCAR); const float2* APOW = (const float2*)(ws + OFF_APOW);
      for (int idx = gt; idx < 16384; idx += ngt) {
          const int b = idx >> 11, gp = idx & 2047;
          const float2 a64 = APOW[(size_t)gp * 65 + 64];
          float hr = 0.f, hi = 0.f;
          for (int c = 0; c < 32; ++c) {
              const size_t off = (size_t)(b * 32 + c) * 2048 + gp;
              HCAR[off] = make_float2(hr, hi);
              const float2 e = HEND[off];
              const float nr = a64.x * hr - a64.y * hi + e.x, ni = a64.x * hi + a64.y * hr + e.y;
              hr = nr; hi = ni;
          }
          P.out[O_PRE + (size_t)b * 2048 + gp] = hr; P.out[O_PIM + (size_t)b * 2048 + gp] = hi;
      } }
}

DI void s5_pass2(const Params& P, unsigned char* lds) {
    unsigned char* ws = P.ws;
    const int tid = threadIdx.x, lane = tid & 63, wid = tid >> 6, gw = blockIdx.x * 8 + wid, nw = gridDim.x * 8, fr = lane & 15, fq = lane >> 4;
    float* BUw = (float*)(lds + wid * 12800);
    unsigned char* Hw = lds + wid * 12800 + 8448;
    const u16* U = (const u16*)(ws + OFF_U); const u16* BBR = (const u16*)(ws + OFF_BBR); const u16* BBI = (const u16*)(ws + OFF_BBI); const u16* CMT = (const u16*)(ws + OFF_CMT);
    const float2* APOW = (const float2*)(ws + OFF_APOW); const float2* HCAR = (const float2*)(ws + OFF_HCAR); u16* G = (u16*)(ws + OFF_G);
    const bf16x8 zero8 = {0, 0, 0, 0, 0, 0, 0, 0};
    for (int T = gw; T < 8192; T += nw) {
        const int g = T & 31, bc = T >> 5, p = lane;
        const int tok0 = (bc >> 5) * 2048 + (bc & 31) * 64;
        const float2 A = APOW[(size_t)(g * 64 + p) * 65 + 1];
        const float2 hc = HCAR[(size_t)bc * 2048 + g * 64 + p];
        float hr = hc.x, hi = hc.y;
        bf16x8 bfr[8], cfr[4];
#pragma unroll
        for (int nt = 0; nt < 8; ++nt) { const u16* src = ((nt & 1) ? BBI : BBR) + (size_t)(g * 64 + (nt >> 1) * 16 + fr) * 16 + 8 * (fq & 1); bfr[nt] = (fq < 2) ? *(const bf16x8*)src : zero8; }
#pragma unroll
        for (int ks = 0; ks < 4; ++ks) cfr[ks] = *(const bf16x8*)(CMT + (size_t)(g * 16 + fr) * 128 + ks * 32 + fq * 8);
        const float dd = P.in[14][g * 16 + fr];
        const int cre_col = (p >> 4) * 32 + (p & 15);
        for (int tt = 0; tt < 4; ++tt) {
            const int tokb = tok0 + tt * 16;
            const bf16x8 a = (fq < 2) ? *(const bf16x8*)(U + (size_t)(tokb + fr) * 512 + g * 16 + 8 * (fq & 1)) : zero8;
#pragma unroll
            for (int nt = 0; nt < 8; ++nt) {
                f32x4 c = {0.f, 0.f, 0.f, 0.f};
                c = MFMA16(a, bfr[nt], c);
#pragma unroll
                for (int j = 0; j < 4; ++j) BUw[(4 * fq + j) * 132 + nt * 16 + fr] = c[j];
            }
            wave_lds_sync();
#pragma unroll
            for (int t = 0; t < 16; ++t) {
                const float bur = BUw[t * 132 + cre_col], bui = BUw[t * 132 + cre_col + 16];
                const float nr = A.x * hr - A.y * hi + bur, ni = A.x * hi + A.y * hr + bui;
                hr = nr; hi = ni;
                *(unsigned*)(Hw + t * 272 + 4 * p) = pk2(hr, hi);
            }
            wave_lds_sync();
            f32x4 y = {0.f, 0.f, 0.f, 0.f};
#pragma unroll
            for (int ks = 0; ks < 4; ++ks) { const bf16x8 af = *(const bf16x8*)(Hw + fr * 272 + (ks * 32 + fq * 8) * 2); y = MFMA16(af, cfr[ks], y); }
#pragma unroll
            for (int j = 0; j < 4; ++j) {
                const size_t tok = (size_t)(tokb + 4 * fq + j);
                const float yy = y[j] + dd * bf2f(U[tok * 512 + g * 16 + fr]);
                G[tok * 512 + g * 16 + fr] = f2bf(geluf_(yy));
            }
            wave_lds_sync();
        }
    }
}

DI void phase_final_norm(const Params& P) {
    const float* ssq = (const float*)(P.ws + OFF_SSQ); const float* gf = P.in[20];
    const int gt = blockIdx.x * NTHR + threadIdx.x, ngt = gridDim.x * NTHR;
    for (int i = gt; i < NTOK * 256; i += ngt) {
        const int r = i >> 8, c4 = (i & 255) * 4;
        const float rstd = rsqrtf(ssq[r] * (1.0f / 1024.0f) + EPSF);
        f32x4 v = *(f32x4*)(P.out + (size_t)r * 1024 + c4);
        const f32x4 g4 = *(const f32x4*)(gf + c4);
        v = v * rstd * g4;
        *(f32x4*)(P.out + (size_t)r * 1024 + c4) = v;
    }
}

__global__ __launch_bounds__(512, 2) void fwd_megakernel(Params P) {
    extern __shared__ __attribute__((aligned(16))) unsigned char shm[];
    cg::grid_group grid = cg::this_grid();
    unsigned char* ws = P.ws;
    pg8::StaticOrder S;
    phase_prep(P, shm);
    grid.sync();
    { pg8::Gemm g; g.A = (const pg8::bf16_t*)(ws + OFF_HB); g.Bt = (const pg8::bf16_t*)(ws + OFF_WIN); g.M = NTOK; g.N = 3072; g.K = 1024;
      S.init(g.M, g.N, (int)gridDim.x, (int)blockIdx.x); EpiProj E; E.ws = ws;
      pg8::gemm_phase<EpiProj, pg8::StaticOrder, false>((PG8_LAS unsigned char*)shm, g, S, E, nullptr); }
    grid.sync();
    s5_pass1(P);
    for (int unit = blockIdx.x; unit < 1024; unit += gridDim.x) hgrn_unit<false>(P, shm, unit);
    for (int task = blockIdx.x; task < 512; task += gridDim.x) hgrn_sample(P, shm, task);
    s5_sample(P, shm);
    grid.sync();
    phase_scan(P);
    grid.sync();
    for (int unit = blockIdx.x; unit < 1024; unit += gridDim.x) hgrn_unit<true>(P, shm, unit);
    s5_pass2(P, shm);
    grid.sync();
    { pg8::Gemm g; g.A = (const pg8::bf16_t*)(ws + OFF_G); g.Bt = (const pg8::bf16_t*)(ws + OFF_WGLU); g.M = NTOK; g.N = 512; g.K = 512;
      S.init(g.M, g.N, (int)gridDim.x, (int)blockIdx.x); EpiGlu E; E.ws = ws; E.bglu = P.in[16];
      pg8::gemm_phase<EpiGlu, pg8::StaticOrder, false>((PG8_LAS unsigned char*)shm, g, S, E, nullptr); }
    grid.sync();
    { pg8::Gemm g; g.A = (const pg8::bf16_t*)(ws + OFF_CAT); g.Bt = (const pg8::bf16_t*)(ws + OFF_WOUT); g.M = NTOK; g.N = 1024; g.K = 1024;
      S.init(g.M, g.N, (int)gridDim.x, (int)blockIdx.x); EpiOut E; E.xp = P.in[0]; E.xs = P.in[1]; E.out = P.out; E.ssq = (float*)(ws + OFF_SSQ);
      pg8::gemm_phase<EpiOut, pg8::StaticOrder, false>((PG8_LAS unsigned char*)shm, g, S, E, nullptr); }
    grid.sync();
    phase_final_norm(P);
}

extern "C" void kernel_launch(void* const* d_in, const int* in_sizes, int n_in, void* d_out, int out_size, void* d_ws, size_t ws_size, hipStream_t stream) {
    static int grid_blocks = 0;
    if (!grid_blocks) {
        int dev = 0, cus = 0, per_cu = 0;
        hipGetDevice(&dev);
        hipDeviceGetAttribute(&cus, hipDeviceAttributeMultiprocessorCount, dev);
        hipFuncSetAttribute((const void*)fwd_megakernel, hipFuncAttributeMaxDynamicSharedMemorySize, LDS_BYTES);
        hipOccupancyMaxActiveBlocksPerMultiprocessor(&per_cu, (const void*)fwd_megakernel, NTHR, LDS_BYTES);
        if (per_cu < 1) per_cu = 1;
        if (per_cu > 1) per_cu = 1;
        grid_blocks = cus * per_cu;
        if (ws_size < WS_END) fprintf(stderr, "kernel_launch: workspace too small: %zu < %zu\n", ws_size, (size_t)WS_END);
    }
    Params p{};
    for (int i = 0; i < 21; ++i) p.in[i] = (const float*)d_in[i];
    p.out = (float*)d_out; p.ws = (unsigned char*)d_ws;
    void* args[] = {&p};
    hipError_t e = hipLaunchCooperativeKernel((void*)fwd_megakernel, dim3(grid_blocks), dim3(NTHR), args, LDS_BYTES, stream);
    if (e != hipSuccess) fprintf(stderr, "cooperative launch failed: %s (grid %d)\n", hipGetErrorString(e), grid_blocks);
}
```

```cpp
#include <hip/hip_runtime.h>
#include <hip/hip_cooperative_groups.h>
#include <cstdio>
namespace cg = cooperative_groups;
namespace pg8 {
#define PG8_LAS __attribute__((address_space(3)))
typedef unsigned short bf16_t;
typedef short bf16x8 __attribute__((ext_vector_type(8)));
typedef float f32x4 __attribute__((ext_vector_type(4)));
typedef unsigned u32x4 __attribute__((ext_vector_type(4)));
constexpr int BM = 256, BK = 64, HALF = 128, HTB = HALF * BK * 2  , STAGE_BYTES = 8 * HTB, NXCD = 8, WGM = 8;

__host__ __device__ __forceinline__ int lds_byte(int r, int c) { const int st = (r >> 4) * 2 + (c >> 5), rr = r & 15, cc = c & 31, ob = rr * 64 + cc * 2; return st * 1024 + (ob ^ (((ob >> 9) & 1) << 5)); }
__host__ __device__ __forceinline__ void stage_rc(int b, int& R, int& C) { const int st = b / 1024, sb = b % 1024, swz = sb ^ (((sb >> 9) & 1) << 5); R = (st >> 1) * 16 + swz / 64; C = (st & 1) * 32 + (swz % 64) / 2; }
__host__ __device__ __forceinline__ int perm32(int rho) { const int n = rho >> 4, i = rho & 15; return 8 * (i >> 2) + 4 * n + (i & 3); }

struct Unit { int pm, pn; };
struct Gemm { const bf16_t* A; const bf16_t* Bt; int M, N, K; };

struct StaticOrder {
    int nM, nN, nwg, G, c;
    __host__ __device__ void init(int M, int N, int G_, int c_) { nM = M / BM; nN = N / BM; nwg = nM * nN; G = G_; c = c_; }
    __host__ __device__ bool next(int i, Unit& u) const {
        const long L = (long)i * G + c; if (L >= nwg) return false;
        int wgid = (int)L; { const int q = nwg / NXCD, r = nwg % NXCD, xcd = wgid % NXCD, off = wgid / NXCD; wgid = (xcd < r ? xcd * (q + 1) : r * (q + 1) + (xcd - r) * q) + off; }
        const int nig = WGM * nN, gid = wgid / nig, fm = gid * WGM, gsz = (nM - fm) < WGM ? (nM - fm) : WGM;
        u.pm = fm + ((wgid % nig) % gsz); u.pn = (wgid % nig) / gsz; return true;
    }
    __device__ __forceinline__ void a_ready(const Unit&) const {}
    __device__ __forceinline__ void done(const Unit&) const {}
};
__device__ __forceinline__ unsigned cvt_pk_bf16(float lo, float hi) { unsigned r; asm volatile("v_cvt_pk_bf16_f32 %0, %1, %2" : "=v"(r) : "v"(lo), "v"(hi)); return r; }
template <class Epi, class Sched, bool STAMP = false>
__device__ __forceinline__ void gemm_phase(PG8_LAS unsigned char* lds, const Gemm g, const Sched& S, const Epi& E, unsigned long long* stamps) {
    const int tid = threadIdx.x, wid = __builtin_amdgcn_readfirstlane(tid >> 6), lane = tid & 63, wr = wid >> 2, wc = wid & 3, fr = lane & 15, fq = lane >> 4;
    const int K = g.K, nt = K / BK;
    int ts_lo = 0, ts_hi = 0, nts = 0; const unsigned long long rt_entry = STAMP ? (unsigned long long)wall_clock64() : 0ull;
#define PG8_STAMP() do { if (STAMP && wid == 0 && nts < 64) { const unsigned long long _c = (unsigned long long)clock64(); \
        ts_lo = (lane == nts) ? (int)(unsigned)_c : ts_lo; ts_hi = (lane == nts) ? (int)(unsigned)(_c >> 32) : ts_hi; ++nts; } } while (0)
    PG8_STAMP();
    unsigned voffA[2], voffB[2];
#pragma unroll
    for (int i = 0; i < 2; ++i) { int R, C; stage_rc(tid * 16 + i * 8192, R, C); const int Rb = Epi::PERM ? ((R & ~31) + perm32(R & 31)) : R;
        voffA[i] = (unsigned)(R * K + C) * 2u; voffB[i] = (unsigned)(Rb * K + C) * 2u; }
    const size_t kstep = (size_t)(BK * 2);
    const size_t hstep = (size_t)HALF * K * 2;
    const size_t tstep = 2 * hstep;
    const unsigned ldsw = (unsigned)wid * 1024u;
    const int aoff = lds_byte(wr * 64 + fr, fq * 8), boff = lds_byte(wc * 32 + fr, fq * 8);
#define PG8_SA(b, h) (((b) * 2 + (h)) * HTB)
#define PG8_SB(b, h) ((4 + (b) * 2 + (h)) * HTB)
#define PG8_STAGE(bufoff, gbase, voff) do { _Pragma("unroll") for (int _i = 0; _i < 2; ++_i) \
        __builtin_amdgcn_global_load_lds((const unsigned*)((const char*)(gbase) + (voff)[_i]), (PG8_LAS unsigned*)(lds + (bufoff) + ldsw + _i * 8192), 16, 0, 0); } while (0)
#define PG8_LDA(dst, b, h) do { _Pragma("unroll") for (int m = 0; m < 4; ++m) _Pragma("unroll") for (int k = 0; k < 2; ++k) dst[m][k] = *(const PG8_LAS bf16x8*)(lds + PG8_SA(b, h) + aoff + m * 2048 + k * 1024); } while (0)
#define PG8_LDB(dst, b, h) do { _Pragma("unroll") for (int n = 0; n < 2; ++n) _Pragma("unroll") for (int k = 0; k < 2; ++k) dst[n][k] = *(const PG8_LAS bf16x8*)(lds + PG8_SB(b, h) + boff + n * 2048 + k * 1024); } while (0)
#define PG8_MMA(ai, bj, At, Bt) do { __builtin_amdgcn_s_setprio(1); _Pragma("unroll") for (int m = 0; m < 4; ++m) _Pragma("unroll") for (int n = 0; n < 2; ++n) _Pragma("unroll") for (int k = 0; k < 2; ++k) \
        acc[ai][bj][m][n] = __builtin_amdgcn_mfma_f32_16x16x32_bf16(Bt[n][k], At[m][k], acc[ai][bj][m][n], 0, 0, 0); __builtin_amdgcn_s_setprio(0); } while (0)
#define PG8_WAIT_V(n) asm volatile("s_waitcnt vmcnt(" #n ")" ::: "memory")
#define PG8_WAIT_L(n) asm volatile("s_waitcnt lgkmcnt(" #n ")" ::: "memory")
#define PG8_BAR __builtin_amdgcn_s_barrier()
#define PG8_SCHED __builtin_amdgcn_sched_barrier(0)
    Unit cur, nxt; int ui = 0;
    if (!S.next(0, cur)) return;
    f32x4 acc[2][2][4][2];
#pragma unroll
    for (int a = 0; a < 2; ++a)
#pragma unroll
        for (int b = 0; b < 2; ++b)
#pragma unroll
            for (int m = 0; m < 4; ++m)
#pragma unroll
                for (int n = 0; n < 2; ++n) acc[a][b][m][n] = (f32x4){0.f, 0.f, 0.f, 0.f};
    bf16x8 At[4][2], B0[2][2], B1[2][2];
    const char* cA = (const char*)g.A + (size_t)cur.pm * tstep; const char* cB = (const char*)g.Bt + (size_t)cur.pn * tstep;
    S.a_ready(cur);
    PG8_STAGE(PG8_SB(0, 0), cB, voffB); PG8_STAGE(PG8_SA(0, 0), cA, voffA); PG8_STAGE(PG8_SB(0, 1), cB + hstep, voffB); PG8_STAGE(PG8_SA(0, 1), cA + hstep, voffA);
    if (wr == 1) PG8_BAR;
    PG8_WAIT_V(4); PG8_BAR;
    PG8_STAGE(PG8_SB(1, 0), cB + kstep, voffB); PG8_STAGE(PG8_SA(1, 0), cA + kstep, voffA); PG8_STAGE(PG8_SB(1, 1), cB + hstep + kstep, voffB);
    PG8_WAIT_V(6); PG8_BAR;
    PG8_STAMP();
    for (;;) {
        const bool has_next = S.next(ui + 1, nxt);
        const char* nA = has_next ? (const char*)g.A + (size_t)nxt.pm * tstep : cA; const char* nB = has_next ? (const char*)g.Bt + (size_t)nxt.pn * tstep : cB;
        for (int t = 0; t < nt; t += 2) {
            const bool last = (t == nt - 2);
            const char* a1 = cA + (size_t)(t + 1) * kstep;
            const char* a2 = last ? nA : cA + (size_t)(t + 2) * kstep; const char* b2 = last ? nB : cB + (size_t)(t + 2) * kstep;
            const char* a3 = a2 + kstep; const char* b3 = b2 + kstep;
            if (last && has_next) S.a_ready(nxt);
            PG8_LDB(B0, 0, 0); PG8_SCHED; PG8_LDA(At, 0, 0); PG8_STAGE(PG8_SA(1, 1), a1 + hstep, voffA);
            PG8_WAIT_L(8); PG8_BAR; PG8_WAIT_L(0); PG8_MMA(0, 0, At, B0); PG8_BAR; PG8_SCHED;
            PG8_LDB(B1, 0, 1); PG8_STAGE(PG8_SB(0, 0), b2, voffB);
            PG8_BAR; PG8_WAIT_L(0); PG8_MMA(0, 1, At, B1); PG8_BAR;
            PG8_LDA(At, 0, 1); PG8_STAGE(PG8_SA(0, 0), a2, voffA);
            PG8_BAR; PG8_WAIT_L(0); PG8_MMA(1, 0, At, B0); PG8_BAR; PG8_SCHED;
            PG8_STAGE(PG8_SB(0, 1), b2 + hstep, voffB);
            PG8_WAIT_V(6); PG8_BAR; PG8_MMA(1, 1, At, B1); PG8_BAR;
            PG8_LDB(B0, 1, 0); PG8_SCHED; PG8_LDA(At, 1, 0); PG8_STAGE(PG8_SA(0, 1), a2 + hstep, voffA);
            PG8_WAIT_L(8); PG8_BAR; PG8_WAIT_L(0); PG8_MMA(0, 0, At, B0); PG8_BAR; PG8_SCHED;
            PG8_LDB(B1, 1, 1); PG8_STAGE(PG8_SB(1, 0), b3, voffB);
            PG8_BAR; PG8_WAIT_L(0); PG8_MMA(0, 1, At, B1); PG8_BAR;
            PG8_LDA(At, 1, 1); PG8_STAGE(PG8_SA(1, 0), a3, voffA);
            PG8_BAR; PG8_WAIT_L(0); PG8_MMA(1, 0, At, B0); PG8_BAR; PG8_SCHED;
            PG8_STAGE(PG8_SB(1, 1), b3 + hstep, voffB);
            PG8_WAIT_V(6); PG8_BAR; PG8_MMA(1, 1, At, B1); PG8_BAR;
        }
        PG8_STAMP();
        if constexpr (!Epi::AFTER_DRAIN) { E(acc, cur, wr, wc, fr, fq); S.done(cur); }
        PG8_STAMP();
        if (!has_next) break;
#pragma unroll
        for (int a = 0; a < 2; ++a)
#pragma unroll
            for (int b = 0; b < 2; ++b)
#pragma unroll
                for (int m = 0; m < 4; ++m)
#pragma unroll
                    for (int n = 0; n < 2; ++n) acc[a][b][m][n] = (f32x4){0.f, 0.f, 0.f, 0.f};
        cur = nxt; cA = nA; cB = nB; ++ui;
    }
    PG8_WAIT_V(0);
    if (wr == 0) PG8_BAR;
    PG8_BAR;
    if constexpr (Epi::AFTER_DRAIN) { E.fused(acc, cur, wr, wc, fr, fq, lds, wid, lane); S.done(cur); }
    PG8_STAMP();
    if (STAMP && wid == 0) { stamps[lane] = lane < nts ? (((unsigned long long)(unsigned)ts_hi << 32) | (unsigned)ts_lo) : 0ull;
        if (lane == 62) stamps[62] = rt_entry; if (lane == 63) stamps[63] = (unsigned long long)wall_clock64(); }
#undef PG8_STAMP
#undef PG8_SA
#undef PG8_SB
#undef PG8_STAGE
#undef PG8_LDA
#undef PG8_LDB
#undef PG8_MMA
#undef PG8_WAIT_V
#undef PG8_WAIT_L
#undef PG8_BAR
#undef PG8_SCHED
}
}

#define XB_TMO      128
#define XB_XCNT(j)  (256  + 64 * (j))
#define XB_XSUB(j)  (1280 + 64 * (j))
#define XB_XGEN(j)  (2304 + 64 * (j))
#define XB_TOP      3328
#define XB_TOPGEN   3392
#define XCD_BAR_WORDS 3456
#define XB_SPIN_CAP (1u << 18)
#define LAS __attribute__((address_space(3)))

__device__ __forceinline__ unsigned xb_ld(unsigned* p)              { return __hip_atomic_load(p, __ATOMIC_RELAXED, __HIP_MEMORY_SCOPE_AGENT); }
__device__ __forceinline__ unsigned xb_add(unsigned* p, unsigned v) { return __hip_atomic_fetch_add(p, v, __ATOMIC_RELAXED, __HIP_MEMORY_SCOPE_AGENT); }
__device__ __forceinline__ unsigned xb_xcc_id() { return (unsigned)__builtin_amdgcn_s_getreg((3 << 11) | 20) & 0xFu; }
#define XB_SPIN(cond, bar) do { unsigned _sp = 0; while (cond) { __builtin_amdgcn_s_sleep(1); \
    if ((++_sp & 255u) == 0u) { if (xb_ld(&(bar)[XB_TMO])) break; if (_sp > XB_SPIN_CAP) { atomicAdd(&(bar)[XB_TMO], 1u); break; } } } } while (0)

struct XcdBarrier {
    unsigned* bar; unsigned x;
    volatile LAS unsigned* st;
};

__device__ __forceinline__ XcdBarrier xcd_barrier_post(unsigned* bar, volatile LAS unsigned* st) {
    XcdBarrier b; b.bar = bar; b.x = xb_xcc_id(); b.st = st;
    if (threadIdx.x == 0) (void)xb_add(&bar[XB_XCNT(b.x)], 1u);
    return b;
}
__device__ __forceinline__ void xcd_barrier_complete(unsigned* bar, unsigned x, unsigned& nloc, unsigned& nx) {
    const unsigned G = gridDim.x * gridDim.y * gridDim.z;
    unsigned sum, cnt, mine, sp = 0u;
    for (;;) {
        sum = 0u; cnt = 0u; mine = 0u;
#pragma unroll
        for (unsigned j = 0; j < 16; ++j) { const unsigned c = xb_ld(&bar[XB_XCNT(j)]); sum += c; cnt += (c > 0u) ? 1u : 0u; mine = (j == x) ? c : mine; }
        if (sum == G) break;
        __builtin_amdgcn_s_sleep(1);
        if ((++sp & 255u) == 0u) { if (xb_ld(&bar[XB_TMO])) break; if (sp > XB_SPIN_CAP) { atomicAdd(&bar[XB_TMO], 1u); break; } }
    }
    nloc = mine > 0u ? mine : 1u; nx = cnt > 0u ? cnt : 1u;
}

__device__ __forceinline__ void xcd_barrier(const XcdBarrier& b) {
    asm volatile("s_waitcnt vmcnt(0)" ::: "memory");
    __syncthreads();
    if (threadIdx.x == 0) {
        unsigned* bar = b.bar;
        __builtin_amdgcn_s_waitcnt(0);
        unsigned nloc = b.st[0], nx = b.st[1];
        if (nloc == 0u) { xcd_barrier_complete(bar, b.x, nloc, nx); b.st[0] = nloc; b.st[1] = nx; }
        const unsigned old = xb_add(&bar[XB_XSUB(b.x)], 1u);
        const unsigned gen = old / nloc;
        if (old + 1u == (gen + 1u) * nloc) {
            __builtin_amdgcn_fence(__ATOMIC_RELEASE, "agent");
            asm volatile("s_waitcnt vmcnt(0)" ::: "memory");
            const unsigned og = xb_add(&bar[XB_TOP], 1u);
            const unsigned tg = og / nx;
            if (og + 1u == (tg + 1u) * nx) xb_add(&bar[XB_TOPGEN], 1u);
            else XB_SPIN(xb_ld(&bar[XB_TOPGEN]) == tg, bar);
            __builtin_amdgcn_fence(__ATOMIC_ACQUIRE, "agent");
            xb_add(&bar[XB_XGEN(b.x)], 1u);
            asm volatile("s_waitcnt vmcnt(0)" ::: "memory");
        } else {
            XB_SPIN(xb_ld(&bar[XB_XGEN(b.x)]) == gen, bar);
            __builtin_amdgcn_fence(__ATOMIC_ACQUIRE, "agent");
            asm volatile("s_waitcnt vmcnt(0)" ::: "memory");
        }
    }
    __syncthreads();
}


typedef unsigned short u16;
using pg8::bf16x8; using pg8::f32x4; using pg8::u32x4;
typedef float f32x16 __attribute__((ext_vector_type(16)));
typedef short s16x4 __attribute__((ext_vector_type(4)));
typedef _Float16 h16x4 __attribute__((ext_vector_type(4)));
#define DI __device__ __forceinline__
DI int tidx() { int t = (int)threadIdx.x; asm volatile("" : "+v"(t)); return t; }
#define MFMA16(a, b, c) __builtin_amdgcn_mfma_f32_16x16x32_bf16((a), (b), (c), 0, 0, 0)
#define MFMA32(a, b, c) __builtin_amdgcn_mfma_f32_32x32x16_bf16((a), (b), (c), 0, 0, 0)

constexpr int NP = 16384, NTOK = 16896, NTHR = 512;
constexpr float EPSF = 1e-6f;
constexpr size_t SZT = (size_t)NTOK * 512 * 2;
constexpr size_t OFF_HB = 0;
constexpr size_t OFF_WIN = OFF_HB + (size_t)NTOK * 1024 * 2;
constexpr size_t OFF_WGLU = OFF_WIN + (size_t)3072 * 1024 * 2;
constexpr size_t OFF_WOUT = OFF_WGLU + (size_t)512 * 512 * 2;
constexpr size_t OFF_U = OFF_WOUT + (size_t)1024 * 1024 * 2;
constexpr size_t OFF_SZS = OFF_U + SZT;
constexpr size_t OFF_Q = OFF_SZS + SZT;
constexpr size_t OFF_KK = OFF_Q + SZT;
constexpr size_t OFF_V = OFF_KK + SZT;
constexpr size_t OFF_SZH = OFF_V + SZT;
constexpr size_t OFF_LF = OFF_SZH + SZT;
constexpr size_t OFF_G = OFF_LF + (size_t)NTOK * 512 * 4;
constexpr size_t OFF_CAT = OFF_G + SZT;
constexpr size_t OFF_DEC = OFF_CAT + (size_t)NTOK * 1024 * 2;
constexpr size_t OFF_HEND = OFF_DEC + (size_t)1024 * 128 * 4;
constexpr size_t OFF_HCAR = OFF_HEND + (size_t)256 * 2048 * 8;
constexpr size_t OFF_APOW = OFF_HCAR + (size_t)256 * 2048 * 8;
constexpr size_t OFF_BBR = OFF_APOW + (size_t)2048 * 65 * 8;
constexpr size_t OFF_BBI = OFF_BBR + (size_t)2048 * 16 * 2;
constexpr size_t OFF_CMT = OFF_BBI + (size_t)2048 * 16 * 2;
constexpr size_t OFF_LB = OFF_CMT + (size_t)32 * 16 * 128 * 2;
constexpr size_t OFF_SSQ = OFF_LB + 2048;
constexpr size_t OFF_BAR = OFF_SSQ + (size_t)NTOK * 4;
constexpr size_t OFF_CNT = OFF_BAR + (size_t)XCD_BAR_WORDS * 4;
constexpr size_t ZERO_BYTES = (size_t)XCD_BAR_WORDS * 4 + 64 * 256;
constexpr size_t OFF_XS = OFF_CNT + 64 * 256;
constexpr size_t WS_END = OFF_XS + (size_t)64 * 256 * 4 * 4;
constexpr size_t O_Y = 0, O_PRE = 17301504, O_PIM = 17317888, O_PHG = 17334272, O_SRE = 17858560, O_SIM = 18120704, O_SHG = 18382848;
constexpr int LDS_BYTES = 131072 + 16;

struct Params { const float* in[21]; float* out; unsigned char* ws; };

DI u16 f2bf(float f) { unsigned r; asm volatile("v_cvt_pk_bf16_f32 %0, %1, %1" : "=v"(r) : "v"(f)); return (u16)(r & 0xffffu); }
DI float bf2f(u16 h) { return __uint_as_float((unsigned)h << 16); }
DI unsigned pk2(float lo, float hi) { unsigned r; asm volatile("v_cvt_pk_bf16_f32 %0, %1, %2" : "=v"(r) : "v"(lo), "v"(hi)); return r; }
DI float wave_sum(float v) {
#pragma unroll
    for (int o = 32; o > 0; o >>= 1) v += __shfl_xor(v, o);
    return v;
}
DI float sigmoidf_(float x) { return 1.0f / (1.0f + __expf(-x)); }
DI float siluf_(float x) { return x / (1.0f + __expf(-x)); }
DI float geluf_(float x) { const float u = 0.7978845608f * (x + 0.044715f * x * x * x); return x / (1.0f + __expf(-2.0f * u)); }
DI void wave_lds_sync() { __builtin_amdgcn_fence(__ATOMIC_RELEASE, "wavefront"); asm volatile("s_waitcnt lgkmcnt(0)" ::: "memory"); __builtin_amdgcn_wave_barrier(); __builtin_amdgcn_fence(__ATOMIC_ACQUIRE, "wavefront"); }

struct TDesc { const float* src; u16* dst; };
DI TDesc transpose_desc(const Params& P, int item, int t) {
    const float* W; u16* Wt; int K, N, tk, tn;
    if (item < 768) { W = P.in[6]; Wt = (u16*)(P.ws + OFF_WIN); K = 1024; N = 3072; tk = item & 15; tn = item >> 4; }
    else if (item < 832) { const int i2 = item - 768; W = P.in[15]; Wt = (u16*)(P.ws + OFF_WGLU); K = 512; N = 512; tk = i2 & 7; tn = i2 >> 3; }
    else { const int i2 = item - 832; W = P.in[19]; Wt = (u16*)(P.ws + OFF_WOUT); K = 1024; N = 1024; tk = i2 & 15; tn = i2 >> 4; }
    TDesc d; d.src = W + (size_t)(tk * 64 + (t >> 3)) * N + tn * 64 + (t & 7) * 8; d.dst = Wt + (size_t)(tn * 64 + (t >> 3)) * K + tk * 64 + (t & 7) * 8; return d;
}

DI void phase_prep(const Params& P, unsigned char* lds) {
    unsigned char* ws = P.ws;
    const int tid = tidx(), lane = tid & 63, wid = tid >> 6;
    { u16* HB = (u16*)(ws + OFF_HB); const float* ng = P.in[5];
      const int gw = blockIdx.x * 8 + wid, nw = gridDim.x * 8;
      f32x4 g4[4], v[4];
#pragma unroll
      for (int i = 0; i < 4; ++i) g4[i] = *(const f32x4*)(ng + i * 256 + lane * 4);
      int r = gw;
      if (r < NTOK) { const float* xr = (r < NP) ? P.in[0] + (size_t)r * 1024 : P.in[1] + (size_t)(r - NP) * 1024;
#pragma unroll
          for (int i = 0; i < 4; ++i) v[i] = __builtin_nontemporal_load((const f32x4*)(xr + i * 256 + lane * 4)); }
      for (; r < NTOK; r += nw) {
          const int rn = (r + nw < NTOK) ? r + nw : r;
          const float* xn = (rn < NP) ? P.in[0] + (size_t)rn * 1024 : P.in[1] + (size_t)(rn - NP) * 1024;
          f32x4 vn[4];
#pragma unroll
          for (int i = 0; i < 4; ++i) vn[i] = __builtin_nontemporal_load((const f32x4*)(xn + i * 256 + lane * 4));
          float ss = 0.f;
#pragma unroll
          for (int i = 0; i < 4; ++i) ss += v[i][0] * v[i][0] + v[i][1] * v[i][1] + v[i][2] * v[i][2] + v[i][3] * v[i][3];
          ss = wave_sum(ss);
          const float rstd = rsqrtf(ss * (1.0f / 1024.0f) + EPSF);
#pragma unroll
          for (int i = 0; i < 4; ++i) {
              const f32x4 o = v[i] * rstd * g4[i];
              uint2 w; w.x = pk2(o[0], o[1]); w.y = pk2(o[2], o[3]);
              *(uint2*)(HB + (size_t)r * 1024 + i * 256 + lane * 4) = w; v[i] = vn[i]; }
      } }
    { float* tile = (float*)lds;
      int item = blockIdx.x;
      if (item < 1088) {
          TDesc cur = transpose_desc(P, item, tid);
          float4 a = *(const float4*)cur.src, b = *(const float4*)(cur.src + 4);
          for (; item < 1088; item += gridDim.x) {
              const int ni = (item + (int)gridDim.x < 1088) ? item + (int)gridDim.x : item;
              const TDesc nxt = transpose_desc(P, ni, tid);
              const float4 na = *(const float4*)nxt.src, nb = *(const float4*)(nxt.src + 4);
              { float* d = tile + (tid >> 3) * 65 + (tid & 7) * 8; d[0] = a.x; d[1] = a.y; d[2] = a.z; d[3] = a.w; d[4] = b.x; d[5] = b.y; d[6] = b.z; d[7] = b.w; }
              __syncthreads();
              { const int n = tid >> 3, k8 = (tid & 7) * 8; float v[8];
#pragma unroll
                for (int j = 0; j < 8; ++j) v[j] = tile[(k8 + j) * 65 + n];
                u32x4 w; w.x = pk2(v[0], v[1]); w.y = pk2(v[2], v[3]); w.z = pk2(v[4], v[5]); w.w = pk2(v[6], v[7]);
                *(u32x4*)cur.dst = w; }
              __syncthreads();
              a = na; b = nb; cur = nxt;
          }
      } }
    { const int gt = blockIdx.x * NTHR + tid, ngt = gridDim.x * NTHR;
      for (int i = gt; i < 2048 * 65; i += ngt) {
          const int gp = i / 65, j = i - gp * 65, g = gp >> 6;
          const double lr = fmin((double)P.in[7][gp], -1e-4), li = (double)P.in[8][gp], dt = exp((double)P.in[9][g]);
          const double x = li * dt * (double)j; const double n = rint(x * 0.15915494309189535); const double r = x - n * 6.283185307179586;
          const float m = expf((float)(lr * dt * (double)j)), rf = (float)r;
          ((float2*)(ws + OFF_APOW))[i] = make_float2(m * cosf(rf), m * sinf(rf));
      }
      for (int i = gt; i < 2048 * 16; i += ngt) {
          const int gp = i >> 4, c = i & 15, g = gp >> 6, p = gp & 63;
          const double lr = fmin((double)P.in[7][gp], -1e-4), li = (double)P.in[8][gp], dt = exp((double)P.in[9][g]);
          const double x = li * dt; const double n = rint(x * 0.15915494309189535); const double r = x - n * 6.283185307179586;
          const double m = exp(lr * dt); const double are = m * cos(r), aim = m * sin(r);
          const double den = lr * lr + li * li;
          const double zr = ((are - 1.0) * lr + aim * li) / den, zi = (aim * lr - (are - 1.0) * li) / den;
          const double br = (double)P.in[10][i], bi = (double)P.in[11][i];
          ((u16*)(ws + OFF_BBR))[i] = f2bf((float)(zr * br - zi * bi)); ((u16*)(ws + OFF_BBI))[i] = f2bf((float)(zr * bi + zi * br));
          u16* cm = (u16*)(ws + OFF_CMT) + ((size_t)g * 16 + c) * 128;
          cm[2 * p] = f2bf(P.in[12][((size_t)g * 16 + c) * 64 + p]); cm[2 * p + 1] = f2bf(-P.in[13][((size_t)g * 16 + c) * 64 + p]);
      }
      for (int i = gt; i < 512; i += ngt) { const float l0 = P.in[17][i], l1 = P.in[17][512 + i]; ((float*)(ws + OFF_LB))[i] = 1.0f / (1.0f + expf(l1 - l0)); }
      for (int i = gt; i < NTOK; i += ngt) ((float*)(ws + OFF_SSQ))[i] = 0.f;
    }
}

struct EpiProj {
    static constexpr bool PERM = true, AFTER_DRAIN = false;
    unsigned char* ws;
    DI void operator()(const f32x4 (&acc)[2][2][4][2], const pg8::Unit& u, int wr, int wc, int fr, int fq) const {
        const int type = u.pn >> 1;
        const int cbase = (u.pn & 1) * 256 + wc * 32 + 8 * fq;
        const int row0 = u.pm * 256 + wr * 64 + fr;
        if (type == 3) {
            const float* LB = (const float*)(ws + OFF_LB); _Float16* LF = (_Float16*)(ws + OFF_LF);
#pragma unroll
            for (int bj = 0; bj < 2; ++bj) {
                const int col = cbase + bj * 128;
                const f32x4 lb0 = *(const f32x4*)(LB + col), lb1 = *(const f32x4*)(LB + col + 4);
#pragma unroll
                for (int ai = 0; ai < 2; ++ai)
#pragma unroll
                    for (int m = 0; m < 4; ++m) {
                        const size_t row = (size_t)(row0 + ai * 128 + m * 16);
                        f32x4 lf0, lf1;
#pragma unroll
                        for (int j = 0; j < 8; ++j) {
                            float x = (j < 4) ? acc[ai][bj][m][0][j & 3] : acc[ai][bj][m][1][j & 3];
                            const float lb = (j < 4) ? lb0[j & 3] : lb1[j & 3];
                            x = fminf(fmaxf(x, -30.f), 30.f);
                            const float e = __expf(-x), sg = 1.0f / (1.0f + e);
                            const float f = lb + (1.0f - lb) * sg;
                            const float l = __logf(f);
                            if (j < 4) lf0[j & 3] = l; else lf1[j & 3] = l;
                        }
                        *(h16x4*)(LF + row * 512 + col) = __builtin_convertvector(lf0, h16x4); *(h16x4*)(LF + row * 512 + col + 4) = __builtin_convertvector(lf1, h16x4);
                    }
            }
        } else {
            const bool act = (type == 1) || (type == 5);
            u16* O = (u16*)(ws + (type == 0 ? OFF_U : type == 1 ? OFF_SZS : type == 2 ? OFF_Q : type == 4 ? OFF_V : OFF_SZH));
#pragma unroll
            for (int ai = 0; ai < 2; ++ai)
#pragma unroll
                for (int m = 0; m < 4; ++m) {
                    const size_t row = (size_t)(row0 + ai * 128 + m * 16);
#pragma unroll
                    for (int bj = 0; bj < 2; ++bj) {
                        f32x4 v0 = acc[ai][bj][m][0], v1 = acc[ai][bj][m][1];
                        if (act) {
#pragma unroll
                            for (int j = 0; j < 4; ++j) { v0[j] = siluf_(v0[j]); v1[j] = siluf_(v1[j]); }
                        }
                        u32x4 w; w.x = pk2(v0[0], v0[1]); w.y = pk2(v0[2], v0[3]); w.z = pk2(v1[0], v1[1]); w.w = pk2(v1[2], v1[3]);
                        *(u32x4*)(O + row * 512 + cbase + bj * 128) = w;
                    }
                }
        }
    }
};

struct EpiGlu {
    static constexpr bool PERM = true, AFTER_DRAIN = false;
    unsigned char* ws; const float* bglu;
    DI void operator()(const f32x4 (&acc)[2][2][4][2], const pg8::Unit& u, int wr, int wc, int fr, int fq) const {
        const u16* G = (const u16*)(ws + OFF_G); const u16* SZS = (const u16*)(ws + OFF_SZS); u16* CAT = (u16*)(ws + OFF_CAT);
        const int cbase = u.pn * 256 + wc * 32 + 8 * fq;
        const int row0 = u.pm * 256 + wr * 64 + fr;
#pragma unroll
        for (int bj = 0; bj < 2; ++bj) {
            const int col = cbase + bj * 128;
            const f32x4 b0 = *(const f32x4*)(bglu + col), b1 = *(const f32x4*)(bglu + col + 4);
#pragma unroll
            for (int ai = 0; ai < 2; ++ai)
#pragma unroll
                for (int m = 0; m < 4; ++m) {
                    const size_t row = (size_t)(row0 + ai * 128 + m * 16);
                    const u32x4 g8 = *(const u32x4*)(G + row * 512 + col), z8 = *(const u32x4*)(SZS + row * 512 + col);
                    float o[8];
#pragma unroll
                    for (int j = 0; j < 8; ++j) {
                        const float a = ((j < 4) ? acc[ai][bj][m][0][j & 3] : acc[ai][bj][m][1][j & 3]) + ((j < 4) ? b0[j & 3] : b1[j & 3]);
                        const unsigned gw = g8[j >> 1], zw = z8[j >> 1];
                        const float gv = (j & 1) ? __uint_as_float(gw & 0xffff0000u) : __uint_as_float(gw << 16);
                        const float zv = (j & 1) ? __uint_as_float(zw & 0xffff0000u) : __uint_as_float(zw << 16);
                        o[j] = gv * sigmoidf_(a) * zv;
                    }
                    u32x4 w; w.x = pk2(o[0], o[1]); w.y = pk2(o[2], o[3]); w.z = pk2(o[4], o[5]); w.w = pk2(o[6], o[7]);
                    *(u32x4*)(CAT + row * 1024 + col) = w;
                }
        }
    }
};

struct PanelOrder {
    int c;
    __device__ bool next(int i, pg8::Unit& u) const { if (i > 0) return false; u.pm = (c & 7) * 8 + (c >> 5); u.pn = (c >> 3) & 3; return true; }
    DI void a_ready(const pg8::Unit&) const {}
    DI void done(const pg8::Unit&) const {}
};

struct EpiOutNorm {
    static constexpr bool PERM = false, AFTER_DRAIN = true;
    const float* xp; float* out; const float* gfin; float* xs; unsigned* cnt;
    DI void fused(f32x4 (&acc)[2][2][4][2], const pg8::Unit& u, int wr, int wc, int fr, int fq, PG8_LAS unsigned char* lds, int wid, int lane) const {
        PG8_LAS float* Pl = (PG8_LAS float*)lds;
        PG8_LAS float* Sl = (PG8_LAS float*)(lds + 4096);
        const int rl0 = wr * 64 + fr, col0 = u.pn * 256 + wc * 32 + 4 * fq;
#pragma unroll
        for (int ai = 0; ai < 2; ++ai) {
            f32x4 xv[4][2][2];
#pragma unroll
            for (int m = 0; m < 4; ++m)
#pragma unroll
                for (int bj = 0; bj < 2; ++bj)
#pragma unroll
                    for (int n = 0; n < 2; ++n) xv[m][bj][n] = __builtin_nontemporal_load((const f32x4*)(xp + (size_t)(u.pm * 256 + rl0 + ai * 128 + m * 16) * 1024 + col0 + bj * 128 + n * 16));
#pragma unroll
            for (int m = 0; m < 4; ++m) {
                const int rl = rl0 + ai * 128 + m * 16;
                float ss = 0.f;
#pragma unroll
                for (int bj = 0; bj < 2; ++bj)
#pragma unroll
                    for (int n = 0; n < 2; ++n) {
                        const f32x4 r = acc[ai][bj][m][n] + xv[m][bj][n];
                        acc[ai][bj][m][n] = r;
                        ss += r[0] * r[0] + r[1] * r[1] + r[2] * r[2] + r[3] * r[3];
                    }
                ss += __shfl_xor(ss, 16); ss += __shfl_xor(ss, 32);
                if (fq == 0) Pl[rl * 4 + wc] = ss;
            }
        }
        f32x4 g4[2][2];
#pragma unroll
        for (int bj = 0; bj < 2; ++bj)
#pragma unroll
            for (int n = 0; n < 2; ++n) g4[bj][n] = *(const f32x4*)(gfin + col0 + bj * 128 + n * 16);
        __syncthreads();
        const int tid = wid * 64 + lane;
        if (tid < 256) {
            const float t = (Pl[tid * 4 + 0] + Pl[tid * 4 + 1]) + (Pl[tid * 4 + 2] + Pl[tid * 4 + 3]);
            __hip_atomic_store(xs + ((size_t)u.pm * 256 + tid) * 4 + u.pn, t, __ATOMIC_RELAXED, __HIP_MEMORY_SCOPE_AGENT);
        }
        asm volatile("s_waitcnt vmcnt(0)" ::: "memory");
        __syncthreads();
        if (tid == 0) {
            unsigned* c = cnt + (size_t)u.pm * 64;
            __hip_atomic_fetch_add(c, 1u, __ATOMIC_RELAXED, __HIP_MEMORY_SCOPE_AGENT);
            unsigned sp = 0;
            while (__hip_atomic_load(c, __ATOMIC_RELAXED, __HIP_MEMORY_SCOPE_AGENT) < 4u) { __builtin_amdgcn_s_sleep(1); if (++sp > (1u << 22)) break; }
        }
        __syncthreads();
        if (tid < 256) {
            const float* p = xs + ((size_t)u.pm * 256 + tid) * 4;
            const float t = (__hip_atomic_load(p, __ATOMIC_RELAXED, __HIP_MEMORY_SCOPE_AGENT) + __hip_atomic_load(p + 1, __ATOMIC_RELAXED, __HIP_MEMORY_SCOPE_AGENT))
                          + (__hip_atomic_load(p + 2, __ATOMIC_RELAXED, __HIP_MEMORY_SCOPE_AGENT) + __hip_atomic_load(p + 3, __ATOMIC_RELAXED, __HIP_MEMORY_SCOPE_AGENT));
            Sl[tid] = rsqrtf(t * (1.0f / 1024.0f) + EPSF);
        }
        __syncthreads();
#pragma unroll
        for (int ai = 0; ai < 2; ++ai)
#pragma unroll
            for (int m = 0; m < 4; ++m) {
                const int rl = rl0 + ai * 128 + m * 16;
                const float rstd = Sl[rl];
                float* orow = out + (size_t)(u.pm * 256 + rl) * 1024 + col0;
#pragma unroll
                for (int bj = 0; bj < 2; ++bj)
#pragma unroll
                    for (int n = 0; n < 2; ++n) __builtin_nontemporal_store(acc[ai][bj][m][n] * rstd * g4[bj][n], (f32x4*)(orow + bj * 128 + n * 16));
            }
        __syncthreads();
    }
};

template <int NST, class F>
DI void small_gemm_tile(const u16* __restrict__ A, int lda, const u16* __restrict__ Bt, int ldb, int row0, int col0, unsigned char* lds, F&& epi) {
    const int tid = tidx(), lane = tid & 63, wid = __builtin_amdgcn_readfirstlane(tid >> 6), fr = lane & 15, fq = lane >> 4;
    const int koff = wid * (NST * 32) + fq * (NST * 8);
    bf16x8 af[4][NST], bfv[4][NST];
#pragma unroll
    for (int t = 0; t < 4; ++t)
#pragma unroll
        for (int j = 0; j < NST; ++j) {
            af[t][j] = *(const bf16x8*)(A + (size_t)(row0 + t * 16 + fr) * lda + koff + 8 * j);
            bfv[t][j] = *(const bf16x8*)(Bt + (size_t)(col0 + t * 16 + fr) * ldb + koff + 8 * j);
        }
    f32x4 acc[4][4];
#pragma unroll
    for (int m = 0; m < 4; ++m)
#pragma unroll
        for (int n = 0; n < 4; ++n) acc[m][n] = (f32x4){0.f, 0.f, 0.f, 0.f};
#pragma unroll
    for (int j = 0; j < NST; ++j)
#pragma unroll
        for (int m = 0; m < 4; ++m)
#pragma unroll
            for (int n = 0; n < 4; ++n) acc[m][n] = MFMA16(bfv[n][j], af[m][j], acc[m][n]);
    f32x4* Pw = (f32x4*)lds;
#pragma unroll
    for (int m = 0; m < 4; ++m)
#pragma unroll
        for (int n = 0; n < 4; ++n) Pw[(wid * 64 + m * 16 + fr) * 16 + ((n * 4 + fq) ^ fr)] = acc[m][n];
    __syncthreads();
    { const int row = tid >> 3;
#pragma unroll
      for (int h = 0; h < 2; ++h) {
          const int slot = (tid & 7) * 2 + h;
          f32x4 v = {0.f, 0.f, 0.f, 0.f};
#pragma unroll
          for (int w = 0; w < 8; ++w) v += Pw[(w * 64 + row) * 16 + (slot ^ (row & 15))];
          epi(row0 + row, col0 + slot * 4, v);
      } }
    __syncthreads();
}

template <int NST, class PRE, class F>
DI void small_gemm_tile_pre(const u16* __restrict__ A, int lda, const u16* __restrict__ Bt, int ldb, int row0, int col0, unsigned char* lds, PRE&& pre, F&& epi) {
    const int tid = tidx(), lane = tid & 63, wid = __builtin_amdgcn_readfirstlane(tid >> 6), fr = lane & 15, fq = lane >> 4;
    const int koff = wid * (NST * 32) + fq * (NST * 8);
    bf16x8 af[4][NST], bfv[4][NST];
#pragma unroll
    for (int t = 0; t < 4; ++t)
#pragma unroll
        for (int j = 0; j < NST; ++j) {
            af[t][j] = *(const bf16x8*)(A + (size_t)(row0 + t * 16 + fr) * lda + koff + 8 * j);
            bfv[t][j] = *(const bf16x8*)(Bt + (size_t)(col0 + t * 16 + fr) * ldb + koff + 8 * j);
        }
    f32x4 pvv[2];
#pragma unroll
    for (int h = 0; h < 2; ++h) pvv[h] = pre(row0 + (tid >> 3), col0 + ((tid & 7) * 2 + h) * 4);
    f32x4 acc[4][4];
#pragma unroll
    for (int m = 0; m < 4; ++m)
#pragma unroll
        for (int n = 0; n < 4; ++n) acc[m][n] = (f32x4){0.f, 0.f, 0.f, 0.f};
#pragma unroll
    for (int j = 0; j < NST; ++j)
#pragma unroll
        for (int m = 0; m < 4; ++m)
#pragma unroll
            for (int n = 0; n < 4; ++n) acc[m][n] = MFMA16(bfv[n][j], af[m][j], acc[m][n]);
    f32x4* Pw = (f32x4*)lds;
#pragma unroll
    for (int m = 0; m < 4; ++m)
#pragma unroll
        for (int n = 0; n < 4; ++n) Pw[(wid * 64 + m * 16 + fr) * 16 + ((n * 4 + fq) ^ fr)] = acc[m][n];
    __syncthreads();
    { const int row = tid >> 3;
#pragma unroll
      for (int h = 0; h < 2; ++h) {
          const int slot = (tid & 7) * 2 + h;
          f32x4 v = {0.f, 0.f, 0.f, 0.f};
#pragma unroll
          for (int w = 0; w < 8; ++w) v += Pw[(w * 64 + row) * 16 + (slot ^ (row & 15))];
          epi(row0 + row, col0 + slot * 4, v, pvv[h]);
      } }
    __syncthreads();
}

DI void proj_store4(unsigned char* ws, int row, int col, f32x4 v) {
    const int type = col >> 9, cc = col & 511; const size_t o = (size_t)row * 512 + cc;
    if (type == 3) {
        const f32x4 lb = *(const f32x4*)((const float*)(ws + OFF_LB) + cc);
        f32x4 lf;
#pragma unroll
        for (int j = 0; j < 4; ++j) { const float x = fminf(fmaxf(v[j], -30.f), 30.f); const float e = __expf(-x), sg = 1.0f / (1.0f + e); lf[j] = __logf(lb[j] + (1.0f - lb[j]) * sg); }
        *(h16x4*)((_Float16*)(ws + OFF_LF) + o) = __builtin_convertvector(lf, h16x4);
    } else {
        if (type == 1 || type == 5) {
#pragma unroll
            for (int j = 0; j < 4; ++j) v[j] = siluf_(v[j]);
        }
        u16* O = (u16*)(ws + (type == 0 ? OFF_U : type == 1 ? OFF_SZS : type == 2 ? OFF_Q : type == 4 ? OFF_V : OFF_SZH));
        uint2 w; w.x = pk2(v[0], v[1]); w.y = pk2(v[2], v[3]); *(uint2*)(O + o) = w;
    }
}

DI void s5_pass1(const Params& P) {
    unsigned char* ws = P.ws;
    const int tid = tidx(), lane = tid & 63, wid = tid >> 6, gw = blockIdx.x * 8 + wid, nw = gridDim.x * 8;
    const int n = lane & 31, h = lane >> 5;
    const u16* U = (const u16*)(ws + OFF_U); const u16* BBR = (const u16*)(ws + OFF_BBR); const u16* BBI = (const u16*)(ws + OFF_BBI);
    const float2* APOW = (const float2*)(ws + OFF_APOW); float2* HEND = (float2*)(ws + OFF_HEND);
    const int gh = gw & 63, g = gh >> 1, half = gh & 1, p = half * 32 + n;
    const bf16x8 bre = *(const bf16x8*)(BBR + (size_t)(g * 64 + p) * 16 + 8 * h), bim = *(const bf16x8*)(BBI + (size_t)(g * 64 + p) * 16 + 8 * h);
    const float2* ap = APOW + (size_t)(g * 64 + p) * 65;
    float2 w[16];
#pragma unroll
    for (int i = 0; i < 16; ++i) w[i] = ap[31 - ((i & 3) + 8 * (i >> 2) + 4 * h)];
    const float2 a32 = ap[32];
    const int step = nw >> 6;
    int bc = gw >> 6;
    const u16* ub = U + (size_t)n * 512 + g * 16 + 8 * h;
    bf16x8 a0, a1;
    if (bc < 256) { const int tok0 = (bc >> 5) * 2048 + (bc & 31) * 64; a0 = *(const bf16x8*)(ub + (size_t)tok0 * 512); a1 = *(const bf16x8*)(ub + (size_t)(tok0 + 32) * 512); }
    for (; bc < 256; bc += step) {
        const int bn = (bc + step < 256) ? bc + step : bc;
        const int tokn = (bn >> 5) * 2048 + (bn & 31) * 64;
        const bf16x8 n0 = *(const bf16x8*)(ub + (size_t)tokn * 512), n1 = *(const bf16x8*)(ub + (size_t)(tokn + 32) * 512);
        f32x16 z; for (int i = 0; i < 16; ++i) z[i] = 0.f;
        const f32x16 cr0 = MFMA32(a0, bre, z), ci0 = MFMA32(a0, bim, z), cr1 = MFMA32(a1, bre, z), ci1 = MFMA32(a1, bim, z);
        float e0r = 0.f, e0i = 0.f, e1r = 0.f, e1i = 0.f;
#pragma unroll
        for (int i = 0; i < 16; ++i) {
            e1r += w[i].x * cr1[i] - w[i].y * ci1[i]; e1i += w[i].x * ci1[i] + w[i].y * cr1[i];
            e0r += w[i].x * cr0[i] - w[i].y * ci0[i]; e0i += w[i].x * ci0[i] + w[i].y * cr0[i];
        }
        float tr = e1r + a32.x * e0r - a32.y * e0i, ti = e1i + a32.x * e0i + a32.y * e0r;
        tr += __shfl_xor(tr, 32); ti += __shfl_xor(ti, 32);
        if (h == 0) HEND[(size_t)bc * 2048 + g * 64 + p] = make_float2(tr, ti);
        a0 = n0; a1 = n1;
    }
}

DI void s5_sample(const Params& P, unsigned char* lds) {
    unsigned char* ws = P.ws;
    const int tid = tidx(), lane = tid & 63, wid = tid >> 6, gw = blockIdx.x * 8 + wid, nw = gridDim.x * 8;
    float* Hw = (float*)lds + wid * 512;
    const u16* U = (const u16*)(ws + OFF_U); const u16* BBR = (const u16*)(ws + OFF_BBR); const u16* BBI = (const u16*)(ws + OFF_BBI);
    const float2* APOW = (const float2*)(ws + OFF_APOW); u16* G = (u16*)(ws + OFF_G);
    const int c = lane & 15, qd = lane >> 4, g = gw & 31, p = lane, step = nw >> 5;
    const float2 A = APOW[(size_t)(g * 64 + p) * 65 + 1];
    const u32x4 br0 = *(const u32x4*)(BBR + (size_t)(g * 64 + p) * 16), br1 = *(const u32x4*)(BBR + (size_t)(g * 64 + p) * 16 + 8);
    const u32x4 bi0 = *(const u32x4*)(BBI + (size_t)(g * 64 + p) * 16), bi1 = *(const u32x4*)(BBI + (size_t)(g * 64 + p) * 16 + 8);
    f32x4 crv[4], civ[4];
    { const float* cre = P.in[12] + ((size_t)g * 16 + c) * 64 + qd * 16; const float* cim = P.in[13] + ((size_t)g * 16 + c) * 64 + qd * 16;
#pragma unroll
      for (int i = 0; i < 4; ++i) { crv[i] = *(const f32x4*)(cre + 4 * i); civ[i] = *(const f32x4*)(cim + 4 * i); } }
    const float dd = P.in[14][g * 16 + c];
    int bs = gw >> 5;
    float chr = 0.f, chi = 0.f; u32x4 cu[8]; unsigned cud[4];
    if (bs < 128) {
        chr = P.in[2][(size_t)(bs * 32 + g) * 64 + p]; chi = P.in[3][(size_t)(bs * 32 + g) * 64 + p];
#pragma unroll
        for (int t = 0; t < 4; ++t) { const u16* ur = U + (size_t)(NP + bs * 4 + t) * 512 + g * 16; cu[2 * t] = *(const u32x4*)ur; cu[2 * t + 1] = *(const u32x4*)(ur + 8); cud[t] = ur[c]; }
    }
    for (; bs < 128; bs += step) {
        const int nb = (bs + step < 128) ? bs + step : bs;
        const float nhr = P.in[2][(size_t)(nb * 32 + g) * 64 + p], nhi = P.in[3][(size_t)(nb * 32 + g) * 64 + p];
        u32x4 nu[8]; unsigned nud[4];
#pragma unroll
        for (int t = 0; t < 4; ++t) { const u16* ur = U + (size_t)(NP + nb * 4 + t) * 512 + g * 16; nu[2 * t] = *(const u32x4*)ur; nu[2 * t + 1] = *(const u32x4*)(ur + 8); nud[t] = ur[c]; }
        float hr = chr, hi = chi;
#pragma unroll
        for (int t = 0; t < 4; ++t) {
            const u32x4 u0 = cu[2 * t], u1 = cu[2 * t + 1];
            float bur = 0.f, bui = 0.f;
#pragma unroll
            for (int k = 0; k < 8; ++k) {
                const unsigned uw = (k < 4) ? u0[k & 3] : u1[k & 3];
                const unsigned rw = (k < 4) ? br0[k & 3] : br1[k & 3];
                const unsigned iw = (k < 4) ? bi0[k & 3] : bi1[k & 3];
                const float ul = __uint_as_float(uw << 16), uh = __uint_as_float(uw & 0xffff0000u);
                bur += __uint_as_float(rw << 16) * ul + __uint_as_float(rw & 0xffff0000u) * uh;
                bui += __uint_as_float(iw << 16) * ul + __uint_as_float(iw & 0xffff0000u) * uh;
            }
            const float nr = A.x * hr - A.y * hi + bur, ni = A.x * hi + A.y * hr + bui;
            hr = nr; hi = ni;
            Hw[t * 128 + p] = hr; Hw[t * 128 + 64 + p] = hi;
        }
        P.out[O_SRE + (size_t)(bs * 32 + g) * 64 + p] = hr; P.out[O_SIM + (size_t)(bs * 32 + g) * 64 + p] = hi;
        wave_lds_sync();
#pragma unroll
        for (int t = 0; t < 4; ++t) {
            float a = 0.f;
#pragma unroll
            for (int i = 0; i < 16; ++i) a += crv[i >> 2][i & 3] * Hw[t * 128 + qd * 16 + i] - civ[i >> 2][i & 3] * Hw[t * 128 + 64 + qd * 16 + i];
            a += __shfl_xor(a, 16); a += __shfl_xor(a, 32);
            const size_t tok = (size_t)(NP + bs * 4 + t);
            const float y = a + dd * __uint_as_float(cud[t] << 16);
            if (qd == 0) G[tok * 512 + g * 16 + c] = f2bf(geluf_(y));
        }
        wave_lds_sync();
        chr = nhr; chi = nhi;
#pragma unroll
        for (int i = 0; i < 8; ++i) cu[i] = nu[i];
#pragma unroll
        for (int t = 0; t < 4; ++t) cud[t] = nud[t];
    }
}

struct HCols { float lf[16]; unsigned vq[16]; };
template <bool PASS2>
DI void hgrn_load_cols(const Params& P, int unit, HCols& r) {
    const unsigned char* ws = P.ws;
    const int col = tidx() & 127, segu = __builtin_amdgcn_readfirstlane((int)(tidx() >> 7));
    const int b = unit >> 7, hh = (unit >> 5) & 3, chunk = unit & 31;
    const size_t rb = (size_t)(b * 2048 + chunk * 64 + segu * 16) * 512 + hh * 128;
    const _Float16* lfp = (const _Float16*)(ws + OFF_LF) + rb; const u16* vp = (const u16*)(ws + OFF_V) + rb; const u16* qp = (const u16*)(ws + OFF_Q) + rb;
#pragma unroll
    for (int i = 0; i < 16; ++i) { r.lf[i] = (float)lfp[(size_t)i * 512 + col]; const unsigned v = vp[(size_t)i * 512 + col]; const unsigned q = PASS2 ? (unsigned)qp[(size_t)i * 512 + col] : 0u; r.vq[i] = v | (q << 16); }
}
template <bool PASS2>
DI void hgrn_unit(const Params& P, unsigned char* lds, int unit, const HCols& cur, int next_unit, HCols& nxt) {
    unsigned char* ws = P.ws;
    const int tid = tidx(), lane = tid & 63, wid = __builtin_amdgcn_readfirstlane(tid >> 6), fr = lane & 15, fq = lane >> 4;
    const int b = unit >> 7, hh = (unit >> 5) & 3, chunk = unit & 31;
    const int tokc = b * 2048 + chunk * 64;
    u16* Qt = (u16*)lds;
    u16* Kt = PASS2 ? (u16*)(lds + 17408) : (u16*)lds;
    u16* VT = (u16*)(lds + 34816);
    float* SEG = (float*)(lds + 53248);
    float* SS = (float*)(lds + 55296);
    const u16* SSTu = (const u16*)(ws + OFF_HB) + (size_t)unit * 16384;
    const int tt = wid & 3, vh = wid >> 2;
    bf16x8 asf[4][4]; f32x4 g4e[4]; uint2 ze[4];
    if (PASS2) {
#pragma unroll
        for (int vl = 0; vl < 4; ++vl) { const int v0 = hh * 128 + (vh * 4 + vl) * 16 + 4 * fq; g4e[vl] = *(const f32x4*)(P.in[18] + v0); ze[vl] = *(const uint2*)((const u16*)(ws + OFF_SZH) + (size_t)(tokc + tt * 16 + fr) * 512 + v0); }
#pragma unroll
        for (int vl = 0; vl < 4; ++vl)
#pragma unroll
            for (int ks = 0; ks < 4; ++ks) asf[vl][ks] = *(const bf16x8*)((SSTu + (size_t)(vh * 4 + vl) * 2048 + ks * 32) + (fr * 128 + fq * 8));
    }
    {
        const int col = tid & 127, seg = tid >> 7;
        float c[16], kf[16]; u16 vv[16], qq[16];
#pragma unroll
        for (int i = 0; i < 16; ++i) { c[i] = cur.lf[i]; vv[i] = (u16)(cur.vq[i] & 0xffffu); qq[i] = (u16)(cur.vq[i] >> 16); }
#pragma unroll
        for (int i = 0; i < 16; ++i) kf[i] = 1.0f - __expf(c[i]);
#pragma unroll
        for (int i = 1; i < 16; ++i) c[i] += c[i - 1];
        SEG[seg * 128 + col] = c[15];
        __syncthreads();
        float pre = 0.f, tot = 0.f;
#pragma unroll
        for (int s = 0; s < 4; ++s) { const float v = SEG[s * 128 + col]; tot += v; if (s < seg) pre += v; }
        u32x4 v0, v1;
        v0.x = (unsigned)vv[0] | ((unsigned)vv[1] << 16); v0.y = (unsigned)vv[2] | ((unsigned)vv[3] << 16); v0.z = (unsigned)vv[4] | ((unsigned)vv[5] << 16); v0.w = (unsigned)vv[6] | ((unsigned)vv[7] << 16);
        v1.x = (unsigned)vv[8] | ((unsigned)vv[9] << 16); v1.y = (unsigned)vv[10] | ((unsigned)vv[11] << 16); v1.z = (unsigned)vv[12] | ((unsigned)vv[13] << 16); v1.w = (unsigned)vv[14] | ((unsigned)vv[15] << 16);
        *(u32x4*)(VT + col * 72 + seg * 16) = v0; *(u32x4*)(VT + col * 72 + seg * 16 + 8) = v1;
        if (PASS2) {
#pragma unroll
            for (int i = 0; i < 16; ++i) {
                const float bb = pre + c[i];
                Qt[(seg * 16 + i) * 136 + col] = f2bf(bf2f(qq[i]) * __expf(bb));
                Kt[(seg * 16 + i) * 136 + col] = f2bf(kf[i] * __expf(-bb));
            }
        } else {
            float kh[16];
#pragma unroll
            for (int i = 0; i < 16; ++i) kh[i] = kf[i] * __expf(tot - (pre + c[i]));
            u32x4 k0, k1;
            k0.x = pk2(kh[0], kh[1]); k0.y = pk2(kh[2], kh[3]); k0.z = pk2(kh[4], kh[5]); k0.w = pk2(kh[6], kh[7]);
            k1.x = pk2(kh[8], kh[9]); k1.y = pk2(kh[10], kh[11]); k1.z = pk2(kh[12], kh[13]); k1.w = pk2(kh[14], kh[15]);
            *(u32x4*)(Kt + col * 72 + seg * 16) = k0; *(u32x4*)(Kt + col * 72 + seg * 16 + 8) = k1;
            if (seg == 0) ((float*)(ws + OFF_DEC))[(size_t)unit * 128 + col] = __expf(tot);
        }
        __syncthreads();
    }
    hgrn_load_cols<PASS2>(P, next_unit, nxt);
    if (!PASS2) {
        _Float16* SLOC = (_Float16*)(P.out + O_Y) + (size_t)unit * 16384;
        const int kt = wid;
        const bf16x8 a0 = *(const bf16x8*)(Kt + (kt * 16 + fr) * 72 + fq * 8), a1 = *(const bf16x8*)(Kt + (kt * 16 + fr) * 72 + 32 + fq * 8);
#pragma unroll
        for (int vt = 0; vt < 8; ++vt) {
            f32x4 acc = {0.f, 0.f, 0.f, 0.f};
            const bf16x8 b0 = *(const bf16x8*)(VT + (vt * 16 + fr) * 72 + fq * 8), b1 = *(const bf16x8*)(VT + (vt * 16 + fr) * 72 + 32 + fq * 8);
            acc = MFMA16(a0, b0, acc); acc = MFMA16(a1, b1, acc);
            *(h16x4*)(SLOC + (size_t)(vt * 16 + fr) * 128 + kt * 16 + 4 * fq) = __builtin_convertvector(acc, h16x4);
        }
    } else {
        bf16x8 bq[4];
#pragma unroll
        for (int ks = 0; ks < 4; ++ks) bq[ks] = *(const bf16x8*)(Qt + (tt * 16 + fr) * 136 + ks * 32 + fq * 8);
        float pv[4][4];
#pragma unroll
        for (int st = 0; st < 4; ++st) {
            f32x4 pa = {0.f, 0.f, 0.f, 0.f};
#pragma unroll
            for (int ks = 0; ks < 4; ++ks) { const bf16x8 ak = *(const bf16x8*)(Kt + (st * 16 + fr) * 136 + ks * 32 + fq * 8); pa = MFMA16(ak, bq[ks], pa); }
#pragma unroll
            for (int j = 0; j < 4; ++j) pv[st][j] = ((st * 16 + 4 * fq + j) <= (tt * 16 + fr)) ? pa[j] : 0.f;
        }
        bf16x8 pf[2];
#pragma unroll
        for (int k2 = 0; k2 < 2; ++k2) {
            u32x4 w; w.x = pk2(pv[2 * k2][0], pv[2 * k2][1]); w.y = pk2(pv[2 * k2][2], pv[2 * k2][3]); w.z = pk2(pv[2 * k2 + 1][0], pv[2 * k2 + 1][1]); w.w = pk2(pv[2 * k2 + 1][2], pv[2 * k2 + 1][3]);
            pf[k2] = __builtin_bit_cast(bf16x8, w);
        }
        f32x4 oacc[4]; float ssq = 0.f;
#pragma unroll
        for (int vl = 0; vl < 4; ++vl) {
            const int vt = vh * 4 + vl;
            f32x4 o = {0.f, 0.f, 0.f, 0.f};
#pragma unroll
            for (int k2 = 0; k2 < 2; ++k2) {
                const s16x4 lo = *(const s16x4*)(VT + (vt * 16 + fr) * 72 + 32 * k2 + 4 * fq), hi = *(const s16x4*)(VT + (vt * 16 + fr) * 72 + 32 * k2 + 16 + 4 * fq);
                const bf16x8 av = __builtin_shufflevector(lo, hi, 0, 1, 2, 3, 4, 5, 6, 7);
                o = MFMA16(av, pf[k2], o);
            }
#pragma unroll
            for (int ks = 0; ks < 4; ++ks) o = MFMA16(asf[vl][ks], bq[ks], o);
            oacc[vl] = o; ssq += o[0] * o[0] + o[1] * o[1] + o[2] * o[2] + o[3] * o[3];
        }
        ssq += __shfl_xor(ssq, 16); ssq += __shfl_xor(ssq, 32);
        if (fq == 0) SS[vh * 64 + tt * 16 + fr] = ssq;
        __syncthreads();
        const float rstd = rsqrtf((SS[tt * 16 + fr] + SS[64 + tt * 16 + fr]) * (1.0f / 128.0f) + EPSF);
        const size_t tok = (size_t)(tokc + tt * 16 + fr);
        u16* CAT = (u16*)(ws + OFF_CAT);
#pragma unroll
        for (int vl = 0; vl < 4; ++vl) {
            const int v0 = hh * 128 + (vh * 4 + vl) * 16 + 4 * fq;
            const f32x4 g4 = g4e[vl];
            const uint2 z = ze[vl];
            uint2 w;
            w.x = pk2(oacc[vl][0] * rstd * g4[0] * __uint_as_float(z.x << 16), oacc[vl][1] * rstd * g4[1] * __uint_as_float(z.x & 0xffff0000u));
            w.y = pk2(oacc[vl][2] * rstd * g4[2] * __uint_as_float(z.y << 16), oacc[vl][3] * rstd * g4[3] * __uint_as_float(z.y & 0xffff0000u));
            *(uint2*)(CAT + tok * 1024 + 512 + v0) = w;
        }
    }
    __syncthreads();
}

DI void hgrn_sample_load(const Params& P, int task, f32x4 (&s0v)[8]) {
    const int tid = tidx();
    const float* S0 = P.in[4] + (size_t)task * 16384 + (size_t)((tid >> 5) * 8) * 128 + 4 * (tid & 31);
#pragma unroll
    for (int i = 0; i < 8; ++i) s0v[i] = __builtin_nontemporal_load((const f32x4*)(S0 + (size_t)i * 128));
}
DI void hgrn_sample(const Params& P, unsigned char* lds, int task, const f32x4 (&s0v)[8], int next_task, f32x4 (&s0n)[8]) {
    unsigned char* ws = P.ws;
    const int tid = tidx(), lane = tid & 63, wid = tid >> 6;
    const int bs = task >> 2, hh = task & 3;
    float* QE = (float*)lds;
    float* KH = QE + 512;
    float* EB3 = KH + 512;
    float* VV = EB3 + 128;
    float* RED = VV + 512;
    float* RED2 = RED + 32;
    float* OP = RED2 + 32;
    const size_t tokb = (size_t)(NP + bs * 4);
    const float zfin = bf2f(((const u16*)(ws + OFF_SZH))[(tokb + (tid >> 7)) * 512 + hh * 128 + (tid & 127)]);
    const float gfin_ = P.in[18][hh * 128 + (tid & 127)];
    if (next_task != task) hgrn_sample_load(P, next_task, s0n);
    if (tid < 128) {
        const int k = tid; float lf[4], q[4], kk[4], bb[4];
#pragma unroll
        for (int t = 0; t < 4; ++t) { const size_t o = (tokb + t) * 512 + hh * 128 + k; lf[t] = (float)((const _Float16*)(ws + OFF_LF))[o]; q[t] = bf2f(((const u16*)(ws + OFF_Q))[o]); kk[t] = 1.0f - __expf(lf[t]); }
        bb[0] = lf[0]; bb[1] = bb[0] + lf[1]; bb[2] = bb[1] + lf[2]; bb[3] = bb[2] + lf[3];
#pragma unroll
        for (int t = 0; t < 4; ++t) { QE[t * 128 + k] = q[t] * __expf(bb[t]); KH[t * 128 + k] = kk[t] * __expf(bb[3] - bb[t]); }
        EB3[k] = __expf(bb[3]);
        int idx = 0;
#pragma unroll
        for (int t = 0; t < 4; ++t)
#pragma unroll
            for (int s = 0; s <= t; ++s) { float pr = q[t] * kk[s] * __expf(bb[t] - bb[s]); pr = wave_sum(pr); if (lane == 0) RED[wid * 16 + idx] = pr; ++idx; }
    } else if (tid < 256) {
        const int v = tid - 128;
#pragma unroll
        for (int s = 0; s < 4; ++s) VV[s * 128 + v] = bf2f(((const u16*)(ws + OFF_V))[(tokb + s) * 512 + hh * 128 + v]);
    }
    __syncthreads();
    {
        const int v4 = tid & 31, kg = tid >> 5;
        const float* S0 = P.in[4] + (size_t)(bs * 4 + hh) * 16384; float* SN = P.out + O_SHG + (size_t)(bs * 4 + hh) * 16384;
        f32x4 op[4]; for (int t = 0; t < 4; ++t) op[t] = (f32x4){0.f, 0.f, 0.f, 0.f};
        f32x4 vs[4]; for (int s = 0; s < 4; ++s) vs[s] = *(const f32x4*)(VV + s * 128 + 4 * v4);
#pragma unroll
        for (int i = 0; i < 8; ++i) {
            const int k = kg * 8 + i;
            const f32x4 s4 = s0v[i];
            f32x4 sn = s4 * EB3[k];
#pragma unroll
            for (int t = 0; t < 4; ++t) { op[t] += s4 * QE[t * 128 + k]; sn += vs[t] * KH[t * 128 + k]; }
            __builtin_nontemporal_store(sn, (f32x4*)(SN + (size_t)k * 128 + 4 * v4));
        }
#pragma unroll
        for (int t = 0; t < 4; ++t) *(f32x4*)(OP + (kg * 4 + t) * 128 + 4 * v4) = op[t];
    }
    __syncthreads();
    {
        const int t = tid >> 7, v = tid & 127;
        float o = 0.f;
#pragma unroll
        for (int kg = 0; kg < 16; ++kg) o += OP[(kg * 4 + t) * 128 + v];
        const int tb = (t * (t + 1)) >> 1;
        for (int s = 0; s <= t; ++s) o += (RED[tb + s] + RED[16 + tb + s]) * VV[s * 128 + v];
        const float ss = wave_sum(o * o);
        if (lane == 0) RED2[wid] = ss;
        __syncthreads();
        const float rstd = rsqrtf((RED2[2 * t] + RED2[2 * t + 1]) * (1.0f / 128.0f) + EPSF);
        const size_t tok = tokb + t;
        ((u16*)(ws + OFF_CAT))[tok * 1024 + 512 + hh * 128 + v] = f2bf(o * rstd * gfin_ * zfin);
    }
    __syncthreads();
}

DI void phase_scan(const Params& P) {
    unsigned char* ws = P.ws;
    const int gt = blockIdx.x * NTHR + tidx(), ngt = gridDim.x * NTHR;
    { const _Float16* SLOC = (const _Float16*)(P.out + O_Y); const float* DEC = (const float*)(ws + OFF_DEC); u16* SST = (u16*)(ws + OFF_HB);
      for (int idx = gt; idx < 131072; idx += ngt) {
          const int bh = idx >> 12, rem = idx & 4095, v = rem >> 5, k4 = rem & 31;
          f32x4 S = {0.f, 0.f, 0.f, 0.f};
          for (int c0 = 0; c0 < 32; c0 += 8) {
              f32x4 sl[8], d[8];
#pragma unroll
              for (int c = 0; c < 8; ++c) { const size_t unit = (size_t)bh * 32 + c0 + c;
                  sl[c] = __builtin_convertvector(*(const h16x4*)(SLOC + (unit * 128 + v) * 128 + 4 * k4), f32x4); d[c] = *(const f32x4*)(DEC + unit * 128 + 4 * k4); }
#pragma unroll
              for (int c = 0; c < 8; ++c) { const size_t unit = (size_t)bh * 32 + c0 + c;
                  uint2 w; w.x = pk2(S[0], S[1]); w.y = pk2(S[2], S[3]);
                  *(uint2*)(SST + (unit * 128 + v) * 128 + 4 * k4) = w;
                  S = d[c] * S + sl[c]; }
          }
#pragma unroll
          for (int j = 0; j < 4; ++j) P.out[O_PHG + ((size_t)bh * 128 + 4 * k4 + j) * 128 + v] = S[j];
      } }
}

template <bool FUSE>
DI void s5_pass2(const Params& P, unsigned char* lds) {
    unsigned char* ws = P.ws;
    const int tid = tidx(), lane = tid & 63, wid = tid >> 6, gw = blockIdx.x * 8 + wid, nw = gridDim.x * 8, fr = lane & 15, fq = lane >> 4;
    float* BUw = (float*)(lds + wid * 12800);
    unsigned char* Hw = lds + wid * 12800 + 8448;
    const u16* U = (const u16*)(ws + OFF_U); const u16* BBR = (const u16*)(ws + OFF_BBR); const u16* BBI = (const u16*)(ws + OFF_BBI); const u16* CMT = (const u16*)(ws + OFF_CMT);
    const float2* APOW = (const float2*)(ws + OFF_APOW); u16* G = (u16*)(ws + OFF_G);
    const bf16x8 zero8 = {0, 0, 0, 0, 0, 0, 0, 0};
    const float2* HEND = (const float2*)(ws + OFF_HEND);
    const int sidx = blockIdx.x * NTHR + tid, sbh = sidx >> 12, sv = (sidx & 4095) >> 5, sk4 = sidx & 31;
    const _Float16* slp = (const _Float16*)(P.out + O_Y) + ((size_t)sbh * 32 * 128 + sv) * 128 + 4 * sk4;
    const float* dcp = (const float*)(ws + OFF_DEC) + (size_t)sbh * 32 * 128 + 4 * sk4;
    u16* stp = (u16*)(ws + OFF_HB) + ((size_t)sbh * 32 * 128 + sv) * 128 + 4 * sk4;
    f32x4 S = {0.f, 0.f, 0.f, 0.f};
    h16x4 csl[2], nsl[2]; f32x4 cd[2], nd[2];
    if (FUSE) {
#pragma unroll
        for (int c = 0; c < 2; ++c) { csl[c] = *(const h16x4*)(slp + (size_t)c * 16384); cd[c] = *(const f32x4*)(dcp + (size_t)c * 128); }
    }
    for (int T = gw; T < 2048; T += nw) {
        const bool scan_here = FUSE && (T == gw);
        const int g = T & 31, br = T >> 5, b = br >> 3, run = br & 7, p = lane;
        const float2 A = APOW[(size_t)(g * 64 + p) * 65 + 1];
        const float2 a64 = APOW[(size_t)(g * 64 + p) * 65 + 64];
        float hr = 0.f, hi = 0.f;
        { float2 e[28];
#pragma unroll
          for (int c2 = 0; c2 < 28; ++c2) if (c2 < 4 * run) e[c2] = HEND[(size_t)(b * 32 + c2) * 2048 + g * 64 + p];
#pragma unroll
          for (int c2 = 0; c2 < 28; ++c2) if (c2 < 4 * run) { const float nr = a64.x * hr - a64.y * hi + e[c2].x, ni = a64.x * hi + a64.y * hr + e[c2].y; hr = nr; hi = ni; } }
        bf16x8 bfr[8], cfr[4];
#pragma unroll
        for (int nt = 0; nt < 8; ++nt) { const u16* src = ((nt & 1) ? BBI : BBR) + (size_t)(g * 64 + (nt >> 1) * 16 + fr) * 16 + 8 * (fq & 1); bfr[nt] = (fq < 2) ? *(const bf16x8*)src : zero8; }
#pragma unroll
        for (int ks = 0; ks < 4; ++ks) cfr[ks] = *(const bf16x8*)(CMT + (size_t)(g * 16 + fr) * 128 + ks * 32 + fq * 8);
        bf16x8 dfr;
        { const short dbits = (short)f2bf(P.in[14][g * 16 + fr]);
#pragma unroll
          for (int j = 0; j < 8; ++j) dfr[j] = (fq < 2 && 8 * fq + j == fr) ? dbits : (short)0; }
        const int cre_col = (p >> 4) * 32 + (p & 15);
        const int tok0 = b * 2048 + run * 256;
        const u16* up = U + (size_t)(tok0 + fr) * 512 + g * 16 + 8 * (fq & 1);
        bf16x8 a = (fq < 2) ? *(const bf16x8*)up : zero8;
        bf16x8 a1 = (fq < 2) ? *(const bf16x8*)(up + (size_t)16 * 512) : zero8;
#define S5_BU(AOP) do { _Pragma("unroll") for (int nt = 0; nt < 8; ++nt) { f32x4 c_ = {0.f, 0.f, 0.f, 0.f}; c_ = MFMA16((AOP), bfr[nt], c_); \
            _Pragma("unroll") for (int j = 0; j < 4; ++j) BUw[(4 * fq + j) * 132 + nt * 16 + fr] = c_[j]; } } while (0)
        S5_BU(a);
        wave_lds_sync();
        for (int tt = 0; tt < 16; ++tt) {
            const int tokb = tok0 + tt * 16;
            const bf16x8 a2 = (fq < 2) ? *(const bf16x8*)(up + (size_t)((tt < 14 ? tt + 2 : 15) * 16) * 512) : zero8;
            if (scan_here) {
                const int cn = tt < 15 ? 2 * tt + 2 : 30;
#pragma unroll
                for (int c = 0; c < 2; ++c) { nsl[c] = *(const h16x4*)(slp + (size_t)(cn + c) * 16384); nd[c] = *(const f32x4*)(dcp + (size_t)(cn + c) * 128); }
            }
#pragma unroll
            for (int t = 0; t < 16; ++t) {
                const float bur = BUw[t * 132 + cre_col], bui = BUw[t * 132 + cre_col + 16];
                const float nr = A.x * hr - A.y * hi + bur, ni = A.x * hi + A.y * hr + bui;
                hr = nr; hi = ni;
                *(unsigned*)(Hw + t * 272 + 4 * p) = pk2(hr, hi);
            }
            if (scan_here) {
#pragma unroll
                for (int c = 0; c < 2; ++c) {
                    uint2 w; w.x = pk2(S[0], S[1]); w.y = pk2(S[2], S[3]);
                    *(uint2*)(stp + (size_t)(2 * tt + c) * 16384) = w;
                    S = cd[c] * S + __builtin_convertvector(csl[c], f32x4);
                    csl[c] = nsl[c]; cd[c] = nd[c];
                }
            }
            wave_lds_sync();
            f32x4 y = {0.f, 0.f, 0.f, 0.f};
            y = MFMA16(a, dfr, y);
#pragma unroll
            for (int ks = 0; ks < 4; ++ks) { const bf16x8 af = *(const bf16x8*)(Hw + fr * 272 + (ks * 32 + fq * 8) * 2); y = MFMA16(af, cfr[ks], y); }
            if (tt < 15) S5_BU(a1);
#pragma unroll
            for (int j = 0; j < 4; ++j) {
                const size_t tok = (size_t)(tokb + 4 * fq + j);
                G[tok * 512 + g * 16 + fr] = f2bf(geluf_(y[j]));
            }
            wave_lds_sync();
            a = a1; a1 = a2;
        }
#undef S5_BU
        if (run == 7) { P.out[O_PRE + (size_t)b * 2048 + g * 64 + p] = hr; P.out[O_PIM + (size_t)b * 2048 + g * 64 + p] = hi; }
        if (scan_here) {
#pragma unroll
            for (int j = 0; j < 4; ++j) P.out[O_PHG + ((size_t)sbh * 128 + 4 * sk4 + j) * 128 + sv] = S[j];
        }
    }
}

DI void phase_final_norm(const Params& P) {
    const float* ssq = (const float*)(P.ws + OFF_SSQ); const float* gf = P.in[20];
    const int gt = blockIdx.x * NTHR + tidx(), ngt = gridDim.x * NTHR;
    for (int i = gt; i < (NTOK - NP) * 256; i += ngt) {
        const int r = NP + (i >> 8), c4 = (i & 255) * 4;
        const float rstd = rsqrtf(ssq[r] * (1.0f / 1024.0f) + EPSF);
        f32x4 v = *(f32x4*)(P.out + (size_t)r * 1024 + c4);
        const f32x4 g4 = *(const f32x4*)(gf + c4);
        v = v * rstd * g4;
        *(f32x4*)(P.out + (size_t)r * 1024 + c4) = v;
    }
}

__global__ __launch_bounds__(512, 2) void fwd_megakernel(Params P) {
    extern __shared__ __attribute__((aligned(16))) unsigned char shm[];
    cg::grid_group grid = cg::this_grid();
    unsigned char* ws = P.ws;
    if (ws == nullptr) grid.sync();
    if (threadIdx.x == 0) *(uint4*)(shm + 131072) = make_uint4(0u, 0u, 0u, 0u);
    __syncthreads();
    const XcdBarrier xb = xcd_barrier_post((unsigned*)(ws + OFF_BAR), (volatile LAS unsigned*)(shm + 131072));
    pg8::StaticOrder S;
    phase_prep(P, shm);
    xcd_barrier(xb);
    { pg8::Gemm g; g.A = (const pg8::bf16_t*)(ws + OFF_HB); g.Bt = (const pg8::bf16_t*)(ws + OFF_WIN); g.M = NP; g.N = 3072; g.K = 1024;
      S.init(g.M, g.N, (int)gridDim.x, (int)blockIdx.x); EpiProj E; E.ws = ws;
      pg8::gemm_phase<EpiProj, pg8::StaticOrder, false>((PG8_LAS unsigned char*)shm, g, S, E, nullptr);
      for (int t = blockIdx.x; t < 384; t += gridDim.x) {
          const int rt = t / 48, ct = t - rt * 48;
          small_gemm_tile<4>((const u16*)(ws + OFF_HB), 1024, (const u16*)(ws + OFF_WIN), 1024, NP + rt * 64, ct * 64, shm, [&](int row, int col, f32x4 v) { proj_store4(ws, row, col, v); });
      } }
    xcd_barrier(xb);
    { HCols cur, nxt; hgrn_load_cols<false>(P, blockIdx.x, cur);
      s5_pass1(P);
      for (int unit = blockIdx.x; unit < 1024; unit += gridDim.x) {
          const int nu = unit + (int)gridDim.x;
          hgrn_unit<false>(P, shm, unit, cur, nu < 1024 ? nu : unit, nxt); cur = nxt; } }
    if (blockIdx.x < 512) {
        f32x4 s0a[8], s0b[8]; hgrn_sample_load(P, blockIdx.x, s0a);
        for (int task = blockIdx.x; task < 512; task += gridDim.x) {
            const int nt = task + (int)gridDim.x;
            hgrn_sample(P, shm, task, s0a, nt < 512 ? nt : task, s0b);
#pragma unroll
            for (int i = 0; i < 8; ++i) s0a[i] = s0b[i];
        }
    }
    s5_sample(P, shm);
    xcd_barrier(xb);
    if (gridDim.x == 256) s5_pass2<true>(P, shm);
    else { phase_scan(P); s5_pass2<false>(P, shm); }
    xcd_barrier(xb);
    { pg8::Gemm g; g.A = (const pg8::bf16_t*)(ws + OFF_G); g.Bt = (const pg8::bf16_t*)(ws + OFF_WGLU); g.M = NP; g.N = 512; g.K = 512;
      S.init(g.M, g.N, (int)gridDim.x, (int)blockIdx.x); EpiGlu E; E.ws = ws; E.bglu = P.in[16];
      pg8::gemm_phase<EpiGlu, pg8::StaticOrder, false>((PG8_LAS unsigned char*)shm, g, S, E, nullptr);
      __syncthreads();
      if (gridDim.x == 256) {
          const int c = (int)blockIdx.x;
          const int u0 = c < 128 ? c * 2 : 256 + (c - 128) * 6, nu = c < 128 ? 2 : 6;
          HCols cur, nxt; hgrn_load_cols<true>(P, u0, cur);
          for (int i = 0; i < nu; ++i) { hgrn_unit<true>(P, shm, u0 + i, cur, i + 1 < nu ? u0 + i + 1 : u0 + i, nxt); cur = nxt; }
      } else {
          HCols cur, nxt; if (blockIdx.x < 1024) hgrn_load_cols<true>(P, blockIdx.x, cur);
          for (int unit = blockIdx.x; unit < 1024; unit += gridDim.x) { const int nu2 = unit + (int)gridDim.x; hgrn_unit<true>(P, shm, unit, cur, nu2 < 1024 ? nu2 : unit, nxt); cur = nxt; } }
      const int nbusy = 128 < (int)gridDim.x ? 128 : 0;
      for (int t = (int)blockIdx.x - nbusy; t >= 0 && t < 64; t += (int)gridDim.x - nbusy) {
          const float* bglu = P.in[16];
          small_gemm_tile<2>((const u16*)(ws + OFF_G), 512, (const u16*)(ws + OFF_WGLU), 512, NP + (t >> 3) * 64, (t & 7) * 64, shm, [&](int row, int col, f32x4 v) {
              const size_t o = (size_t)row * 512 + col;
              const f32x4 b4 = *(const f32x4*)(bglu + col);
              const uint2 g2 = *(const uint2*)((const u16*)(ws + OFF_G) + o), z2 = *(const uint2*)((const u16*)(ws + OFF_SZS) + o);
              const float o0 = __uint_as_float(g2.x << 16) * sigmoidf_(v[0] + b4[0]) * __uint_as_float(z2.x << 16);
              const float o1 = __uint_as_float(g2.x & 0xffff0000u) * sigmoidf_(v[1] + b4[1]) * __uint_as_float(z2.x & 0xffff0000u);
              const float o2 = __uint_as_float(g2.y << 16) * sigmoidf_(v[2] + b4[2]) * __uint_as_float(z2.y << 16);
              const float o3 = __uint_as_float(g2.y & 0xffff0000u) * sigmoidf_(v[3] + b4[3]) * __uint_as_float(z2.y & 0xffff0000u);
              uint2 w; w.x = pk2(o0, o1); w.y = pk2(o2, o3);
              *(uint2*)((u16*)(ws + OFF_CAT) + (size_t)row * 1024 + col) = w; });
      } }
    xcd_barrier(xb);
    { pg8::Gemm g; g.A = (const pg8::bf16_t*)(ws + OFF_CAT); g.Bt = (const pg8::bf16_t*)(ws + OFF_WOUT); g.M = NP; g.N = 1024; g.K = 1024;
      PanelOrder PO; PO.c = (int)blockIdx.x;
      EpiOutNorm E; E.xp = P.in[0]; E.out = P.out; E.gfin = P.in[20]; E.xs = (float*)(ws + OFF_XS); E.cnt = (unsigned*)(ws + OFF_CNT);
      pg8::gemm_phase<EpiOutNorm, PanelOrder, false>((PG8_LAS unsigned char*)shm, g, PO, E, nullptr);
      float* ssq = (float*)(ws + OFF_SSQ); const float* xs = P.in[1]; float* out = P.out;
      for (int t = blockIdx.x; t < 128; t += gridDim.x) {
          small_gemm_tile_pre<4>((const u16*)(ws + OFF_CAT), 1024, (const u16*)(ws + OFF_WOUT), 1024, NP + (t >> 4) * 64, (t & 15) * 64, shm,
            [&](int row, int col) { return *(const f32x4*)(xs + (size_t)(row - NP) * 1024 + col); },
            [&](int row, int col, f32x4 v, f32x4 xv) {
              const f32x4 r = v + xv;
              *(f32x4*)(out + (size_t)row * 1024 + col) = r;
              float ss = r[0] * r[0] + r[1] * r[1] + r[2] * r[2] + r[3] * r[3];
              ss += __shfl_xor(ss, 1); ss += __shfl_xor(ss, 2); ss += __shfl_xor(ss, 4);
              if ((threadIdx.x & 7) == 0) atomicAdd(ssq + row, ss); });
      } }
    xcd_barrier(xb);
    phase_final_norm(P);
}

extern "C" void kernel_launch(void* const* d_in, const int* in_sizes, int n_in, void* d_out, int out_size, void* d_ws, size_t ws_size, hipStream_t stream) {
    static int grid_blocks = 0;
    if (!grid_blocks) {
        int dev = 0, cus = 0, per_cu = 0;
        hipGetDevice(&dev);
        hipDeviceGetAttribute(&cus, hipDeviceAttributeMultiprocessorCount, dev);
        hipFuncSetAttribute((const void*)fwd_megakernel, hipFuncAttributeMaxDynamicSharedMemorySize, LDS_BYTES);
        hipOccupancyMaxActiveBlocksPerMultiprocessor(&per_cu, (const void*)fwd_megakernel, NTHR, LDS_BYTES);
        if (per_cu < 1) per_cu = 1;
        if (per_cu > 1) per_cu = 1;
        grid_blocks = cus * per_cu;
        if (grid_blocks != 256) fprintf(stderr, "kernel_launch: built for a 256-CU device (one workgroup per CU); got %d\n", grid_blocks);
        if (ws_size < WS_END) fprintf(stderr, "kernel_launch: workspace too small: %zu < %zu\n", ws_size, (size_t)WS_END);
    }
    if (hipMemsetAsync((unsigned char*)d_ws + OFF_BAR, 0, ZERO_BYTES, stream) != hipSuccess) fprintf(stderr, "kernel_launch: memset of barrier words failed\n");
    Params p{};
    for (int i = 0; i < 21; ++i) p.in[i] = (const float*)d_in[i];
    p.out = (float*)d_out; p.ws = (unsigned char*)d_ws;
    void* args[] = {&p};
    hipError_t e = hipLaunchCooperativeKernel((void*)fwd_megakernel, dim3(grid_blocks), dim3(NTHR), args, LDS_BYTES, stream);
    if (e != hipSuccess) fprintf(stderr, "cooperative launch failed: %s (grid %d)\n", hipGetErrorString(e), grid_blocks);
}
```

```cpp
#include <hip/hip_runtime.h>
#include <hip/hip_cooperative_groups.h>
#include <cstdio>
namespace cg = cooperative_groups;
namespace pg8 {
#define PG8_LAS __attribute__((address_space(3)))
typedef unsigned short bf16_t;
typedef short bf16x8 __attribute__((ext_vector_type(8)));
typedef float f32x4 __attribute__((ext_vector_type(4)));
typedef unsigned u32x4 __attribute__((ext_vector_type(4)));
constexpr int BM = 256, BK = 64, HALF = 128, HTB = HALF * BK * 2  , STAGE_BYTES = 8 * HTB, NXCD = 8, WGM = 8;

__host__ __device__ __forceinline__ int lds_byte(int r, int c) { const int st = (r >> 4) * 2 + (c >> 5), rr = r & 15, cc = c & 31, ob = rr * 64 + cc * 2; return st * 1024 + (ob ^ (((ob >> 9) & 1) << 5)); }
__host__ __device__ __forceinline__ void stage_rc(int b, int& R, int& C) { const int st = b / 1024, sb = b % 1024, swz = sb ^ (((sb >> 9) & 1) << 5); R = (st >> 1) * 16 + swz / 64; C = (st & 1) * 32 + (swz % 64) / 2; }
__host__ __device__ __forceinline__ int perm32(int rho) { const int n = rho >> 4, i = rho & 15; return 8 * (i >> 2) + 4 * n + (i & 3); }

struct Unit { int pm, pn; };
struct Gemm { const bf16_t* A; const bf16_t* Bt; int M, N, K; };

struct StaticOrder {
    int nM, nN, nwg, G, c;
    __host__ __device__ void init(int M, int N, int G_, int c_) { nM = M / BM; nN = N / BM; nwg = nM * nN; G = G_; c = c_; }
    __host__ __device__ bool next(int i, Unit& u) const {
        const long L = (long)i * G + c; if (L >= nwg) return false;
        int wgid = (int)L; { const int q = nwg / NXCD, r = nwg % NXCD, xcd = wgid % NXCD, off = wgid / NXCD; wgid = (xcd < r ? xcd * (q + 1) : r * (q + 1) + (xcd - r) * q) + off; }
        const int nig = WGM * nN, gid = wgid / nig, fm = gid * WGM, gsz = (nM - fm) < WGM ? (nM - fm) : WGM;
        u.pm = fm + ((wgid % nig) % gsz); u.pn = (wgid % nig) / gsz; return true;
    }
    __device__ __forceinline__ void a_ready(const Unit&) const {}
    __device__ __forceinline__ void done(const Unit&) const {}
};
__device__ __forceinline__ unsigned cvt_pk_bf16(float lo, float hi) { unsigned r; asm volatile("v_cvt_pk_bf16_f32 %0, %1, %2" : "=v"(r) : "v"(lo), "v"(hi)); return r; }
template <class Epi, class Sched, bool STAMP = false>
__device__ __forceinline__ void gemm_phase(PG8_LAS unsigned char* lds, const Gemm g, const Sched& S, const Epi& E, unsigned long long* stamps) {
    const int tid = threadIdx.x, wid = __builtin_amdgcn_readfirstlane(tid >> 6), lane = tid & 63, wr = wid >> 2, wc = wid & 3, fr = lane & 15, fq = lane >> 4;
    const int K = g.K, nt = K / BK;
    int ts_lo = 0, ts_hi = 0, nts = 0; const unsigned long long rt_entry = STAMP ? (unsigned long long)wall_clock64() : 0ull;
#define PG8_STAMP() do { if (STAMP && wid == 0 && nts < 64) { const unsigned long long _c = (unsigned long long)clock64(); \
        ts_lo = (lane == nts) ? (int)(unsigned)_c : ts_lo; ts_hi = (lane == nts) ? (int)(unsigned)(_c >> 32) : ts_hi; ++nts; } } while (0)
    PG8_STAMP();
    unsigned voffA[2], voffB[2];
#pragma unroll
    for (int i = 0; i < 2; ++i) { int R, C; stage_rc(tid * 16 + i * 8192, R, C); const int Rb = Epi::PERM ? ((R & ~31) + perm32(R & 31)) : R;
        voffA[i] = (unsigned)(R * K + C) * 2u; voffB[i] = (unsigned)(Rb * K + C) * 2u; }
    const size_t kstep = (size_t)(BK * 2);
    const size_t hstep = (size_t)HALF * K * 2;
    const size_t tstep = 2 * hstep;
    const unsigned ldsw = (unsigned)wid * 1024u;
    const int aoff = lds_byte(wr * 64 + fr, fq * 8), boff = lds_byte(wc * 32 + fr, fq * 8);
#define PG8_SA(b, h) (((b) * 2 + (h)) * HTB)
#define PG8_SB(b, h) ((4 + (b) * 2 + (h)) * HTB)
#define PG8_STAGE(bufoff, gbase, voff) do { _Pragma("unroll") for (int _i = 0; _i < 2; ++_i) \
        __builtin_amdgcn_global_load_lds((const unsigned*)((const char*)(gbase) + (voff)[_i]), (PG8_LAS unsigned*)(lds + (bufoff) + ldsw + _i * 8192), 16, 0, 0); } while (0)
#define PG8_LDA(dst, b, h) do { _Pragma("unroll") for (int m = 0; m < 4; ++m) _Pragma("unroll") for (int k = 0; k < 2; ++k) dst[m][k] = *(const PG8_LAS bf16x8*)(lds + PG8_SA(b, h) + aoff + m * 2048 + k * 1024); } while (0)
#define PG8_LDB(dst, b, h) do { _Pragma("unroll") for (int n = 0; n < 2; ++n) _Pragma("unroll") for (int k = 0; k < 2; ++k) dst[n][k] = *(const PG8_LAS bf16x8*)(lds + PG8_SB(b, h) + boff + n * 2048 + k * 1024); } while (0)
#define PG8_MMA(ai, bj, At, Bt) do { __builtin_amdgcn_s_setprio(1); _Pragma("unroll") for (int m = 0; m < 4; ++m) _Pragma("unroll") for (int n = 0; n < 2; ++n) _Pragma("unroll") for (int k = 0; k < 2; ++k) \
        acc[ai][bj][m][n] = __builtin_amdgcn_mfma_f32_16x16x32_bf16(Bt[n][k], At[m][k], acc[ai][bj][m][n], 0, 0, 0); __builtin_amdgcn_s_setprio(0); } while (0)
#define PG8_WAIT_V(n) asm volatile("s_waitcnt vmcnt(" #n ")" ::: "memory")
#define PG8_WAIT_L(n) asm volatile("s_waitcnt lgkmcnt(" #n ")" ::: "memory")
#define PG8_BAR __builtin_amdgcn_s_barrier()
#define PG8_SCHED __builtin_amdgcn_sched_barrier(0)
    Unit cur, nxt; int ui = 0;
    if (!S.next(0, cur)) return;
    f32x4 acc[2][2][4][2];
#pragma unroll
    for (int a = 0; a < 2; ++a)
#pragma unroll
        for (int b = 0; b < 2; ++b)
#pragma unroll
            for (int m = 0; m < 4; ++m)
#pragma unroll
                for (int n = 0; n < 2; ++n) acc[a][b][m][n] = (f32x4){0.f, 0.f, 0.f, 0.f};
    bf16x8 At[4][2], B0[2][2], B1[2][2];
    const char* cA = (const char*)g.A + (size_t)cur.pm * tstep; const char* cB = (const char*)g.Bt + (size_t)cur.pn * tstep;
    S.a_ready(cur);
    PG8_STAGE(PG8_SB(0, 0), cB, voffB); PG8_STAGE(PG8_SA(0, 0), cA, voffA); PG8_STAGE(PG8_SB(0, 1), cB + hstep, voffB); PG8_STAGE(PG8_SA(0, 1), cA + hstep, voffA);
    if (wr == 1) PG8_BAR;
    PG8_WAIT_V(4); PG8_BAR;
    PG8_STAGE(PG8_SB(1, 0), cB + kstep, voffB); PG8_STAGE(PG8_SA(1, 0), cA + kstep, voffA); PG8_STAGE(PG8_SB(1, 1), cB + hstep + kstep, voffB);
    PG8_WAIT_V(6); PG8_BAR;
    PG8_STAMP();
    for (;;) {
        const bool has_next = S.next(ui + 1, nxt);
        const char* nA = has_next ? (const char*)g.A + (size_t)nxt.pm * tstep : cA; const char* nB = has_next ? (const char*)g.Bt + (size_t)nxt.pn * tstep : cB;
        for (int t = 0; t < nt; t += 2) {
            const bool last = (t == nt - 2);
            const char* a1 = cA + (size_t)(t + 1) * kstep;
            const char* a2 = last ? nA : cA + (size_t)(t + 2) * kstep; const char* b2 = last ? nB : cB + (size_t)(t + 2) * kstep;
            const char* a3 = a2 + kstep; const char* b3 = b2 + kstep;
            if (last && has_next) S.a_ready(nxt);
            PG8_LDB(B0, 0, 0); PG8_SCHED; PG8_LDA(At, 0, 0); PG8_STAGE(PG8_SA(1, 1), a1 + hstep, voffA);
            PG8_WAIT_L(8); PG8_BAR; PG8_WAIT_L(0); PG8_MMA(0, 0, At, B0); PG8_BAR; PG8_SCHED;
            PG8_LDB(B1, 0, 1); PG8_STAGE(PG8_SB(0, 0), b2, voffB);
            PG8_BAR; PG8_WAIT_L(0); PG8_MMA(0, 1, At, B1); PG8_BAR;
            PG8_LDA(At, 0, 1); PG8_STAGE(PG8_SA(0, 0), a2, voffA);
            PG8_BAR; PG8_WAIT_L(0); PG8_MMA(1, 0, At, B0); PG8_BAR; PG8_SCHED;
            PG8_STAGE(PG8_SB(0, 1), b2 + hstep, voffB);
            PG8_WAIT_V(6); PG8_BAR; PG8_MMA(1, 1, At, B1); PG8_BAR;
            PG8_LDB(B0, 1, 0); PG8_SCHED; PG8_LDA(At, 1, 0); PG8_STAGE(PG8_SA(0, 1), a2 + hstep, voffA);
            PG8_WAIT_L(8); PG8_BAR; PG8_WAIT_L(0); PG8_MMA(0, 0, At, B0); PG8_BAR; PG8_SCHED;
            PG8_LDB(B1, 1, 1); PG8_STAGE(PG8_SB(1, 0), b3, voffB);
            PG8_BAR; PG8_WAIT_L(0); PG8_MMA(0, 1, At, B1); PG8_BAR;
            PG8_LDA(At, 1, 1); PG8_STAGE(PG8_SA(1, 0), a3, voffA);
            PG8_BAR; PG8_WAIT_L(0); PG8_MMA(1, 0, At, B0); PG8_BAR; PG8_SCHED;
            PG8_STAGE(PG8_SB(1, 1), b3 + hstep, voffB);
            PG8_WAIT_V(6); PG8_BAR; PG8_MMA(1, 1, At, B1); PG8_BAR;
        }
        PG8_STAMP();
        if constexpr (!Epi::AFTER_DRAIN) { E(acc, cur, wr, wc, fr, fq); S.done(cur); }
        PG8_STAMP();
        if (!has_next) break;
#pragma unroll
        for (int a = 0; a < 2; ++a)
#pragma unroll
            for (int b = 0; b < 2; ++b)
#pragma unroll
                for (int m = 0; m < 4; ++m)
#pragma unroll
                    for (int n = 0; n < 2; ++n) acc[a][b][m][n] = (f32x4){0.f, 0.f, 0.f, 0.f};
        cur = nxt; cA = nA; cB = nB; ++ui;
    }
    PG8_WAIT_V(0);
    if (wr == 0) PG8_BAR;
    PG8_BAR;
    if constexpr (Epi::AFTER_DRAIN) { E.fused(acc, cur, wr, wc, fr, fq, lds, wid, lane); S.done(cur); }
    PG8_STAMP();
    if (STAMP && wid == 0) { stamps[lane] = lane < nts ? (((unsigned long long)(unsigned)ts_hi << 32) | (unsigned)ts_lo) : 0ull;
        if (lane == 62) stamps[62] = rt_entry; if (lane == 63) stamps[63] = (unsigned long long)wall_clock64(); }
#undef PG8_STAMP
#undef PG8_SA
#undef PG8_SB
#undef PG8_STAGE
#undef PG8_LDA
#undef PG8_LDB
#undef PG8_MMA
#undef PG8_WAIT_V
#undef PG8_WAIT_L
#undef PG8_BAR
#undef PG8_SCHED
}
}

#define XB_TMO      128
#define XB_XCNT(j)  (256  + 64 * (j))
#define XB_XSUB(j)  (1280 + 64 * (j))
#define XB_XGEN(j)  (2304 + 64 * (j))
#define XB_TOP      3328
#define XB_TOPGEN   3392
#define XCD_BAR_WORDS 3456
#define XB_SPIN_CAP (1u << 18)
#define LAS __attribute__((address_space(3)))

__device__ __forceinline__ unsigned xb_ld(unsigned* p)              { return __hip_atomic_load(p, __ATOMIC_RELAXED, __HIP_MEMORY_SCOPE_AGENT); }
__device__ __forceinline__ unsigned xb_add(unsigned* p, unsigned v) { return __hip_atomic_fetch_add(p, v, __ATOMIC_RELAXED, __HIP_MEMORY_SCOPE_AGENT); }
__device__ __forceinline__ unsigned xb_xcc_id() { return (unsigned)__builtin_amdgcn_s_getreg((3 << 11) | 20) & 0xFu; }
#define XB_SPIN(cond, bar) do { unsigned _sp = 0; while (cond) { __builtin_amdgcn_s_sleep(1); \
    if ((++_sp & 255u) == 0u) { if (xb_ld(&(bar)[XB_TMO])) break; if (_sp > XB_SPIN_CAP) { atomicAdd(&(bar)[XB_TMO], 1u); break; } } } } while (0)

struct XcdBarrier {
    unsigned* bar; unsigned x;
    volatile LAS unsigned* st;
};

__device__ __forceinline__ XcdBarrier xcd_barrier_post(unsigned* bar, volatile LAS unsigned* st) {
    XcdBarrier b; b.bar = bar; b.x = xb_xcc_id(); b.st = st;
    if (threadIdx.x == 0) (void)xb_add(&bar[XB_XCNT(b.x)], 1u);
    return b;
}
__device__ __forceinline__ void xcd_barrier_complete(unsigned* bar, unsigned x, unsigned& nloc, unsigned& nx) {
    const unsigned G = gridDim.x * gridDim.y * gridDim.z;
    unsigned sum, cnt, mine, sp = 0u;
    for (;;) {
        sum = 0u; cnt = 0u; mine = 0u;
#pragma unroll
        for (unsigned j = 0; j < 16; ++j) { const unsigned c = xb_ld(&bar[XB_XCNT(j)]); sum += c; cnt += (c > 0u) ? 1u : 0u; mine = (j == x) ? c : mine; }
        if (sum == G) break;
        __builtin_amdgcn_s_sleep(1);
        if ((++sp & 255u) == 0u) { if (xb_ld(&bar[XB_TMO])) break; if (sp > XB_SPIN_CAP) { atomicAdd(&bar[XB_TMO], 1u); break; } }
    }
    nloc = mine > 0u ? mine : 1u; nx = cnt > 0u ? cnt : 1u;
}

__device__ __forceinline__ void xcd_barrier(const XcdBarrier& b) {
    asm volatile("s_waitcnt vmcnt(0)" ::: "memory");
    __syncthreads();
    if (threadIdx.x == 0) {
        unsigned* bar = b.bar;
        __builtin_amdgcn_s_waitcnt(0);
        unsigned nloc = b.st[0], nx = b.st[1];
        if (nloc == 0u) { xcd_barrier_complete(bar, b.x, nloc, nx); b.st[0] = nloc; b.st[1] = nx; }
        const unsigned old = xb_add(&bar[XB_XSUB(b.x)], 1u);
        const unsigned gen = old / nloc;
        if (old + 1u == (gen + 1u) * nloc) {
            __builtin_amdgcn_fence(__ATOMIC_RELEASE, "agent");
            asm volatile("s_waitcnt vmcnt(0)" ::: "memory");
            const unsigned og = xb_add(&bar[XB_TOP], 1u);
            const unsigned tg = og / nx;
            if (og + 1u == (tg + 1u) * nx) xb_add(&bar[XB_TOPGEN], 1u);
            else XB_SPIN(xb_ld(&bar[XB_TOPGEN]) == tg, bar);
            __builtin_amdgcn_fence(__ATOMIC_ACQUIRE, "agent");
            xb_add(&bar[XB_XGEN(b.x)], 1u);
            asm volatile("s_waitcnt vmcnt(0)" ::: "memory");
        } else {
            XB_SPIN(xb_ld(&bar[XB_XGEN(b.x)]) == gen, bar);
            __builtin_amdgcn_fence(__ATOMIC_ACQUIRE, "agent");
            asm volatile("s_waitcnt vmcnt(0)" ::: "memory");
        }
    }
    __syncthreads();
}


typedef unsigned short u16;
using pg8::bf16x8; using pg8::f32x4; using pg8::u32x4;
typedef float f32x16 __attribute__((ext_vector_type(16)));
typedef short s16x4 __attribute__((ext_vector_type(4)));
typedef _Float16 h16x4 __attribute__((ext_vector_type(4)));
#define DI __device__ __forceinline__
DI int tidx() { int t = (int)threadIdx.x; asm volatile("" : "+v"(t)); return t; }
#define MFMA16(a, b, c) __builtin_amdgcn_mfma_f32_16x16x32_bf16((a), (b), (c), 0, 0, 0)
#define MFMA32(a, b, c) __builtin_amdgcn_mfma_f32_32x32x16_bf16((a), (b), (c), 0, 0, 0)

constexpr int NP = 16384, NTOK = 16896, NTHR = 512;
constexpr float EPSF = 1e-6f;
constexpr size_t SZT = (size_t)NTOK * 512 * 2;
constexpr size_t OFF_HB = 0;
constexpr size_t OFF_WIN = OFF_HB + (size_t)NTOK * 1024 * 2;
constexpr size_t OFF_WGLU = OFF_WIN + (size_t)3072 * 1024 * 2;
constexpr size_t OFF_WOUT = OFF_WGLU + (size_t)512 * 512 * 2;
constexpr size_t OFF_U = OFF_WOUT + (size_t)1024 * 1024 * 2;
constexpr size_t OFF_SZS = OFF_U + SZT;
constexpr size_t OFF_Q = OFF_SZS + SZT;
constexpr size_t OFF_KK = OFF_Q + SZT;
constexpr size_t OFF_V = OFF_KK + SZT;
constexpr size_t OFF_SZH = OFF_V + SZT;
constexpr size_t OFF_LF = OFF_SZH + SZT;
constexpr size_t OFF_G = OFF_LF + (size_t)NTOK * 512 * 4;
constexpr size_t OFF_CAT = OFF_G + SZT;
constexpr size_t OFF_DEC = OFF_CAT + (size_t)NTOK * 1024 * 2;
constexpr size_t OFF_HEND = OFF_DEC + (size_t)1024 * 128 * 4;
constexpr size_t OFF_HCAR = OFF_HEND + (size_t)256 * 2048 * 8;
constexpr size_t OFF_APOW = OFF_HCAR + (size_t)256 * 2048 * 8;
constexpr size_t OFF_BBR = OFF_APOW + (size_t)2048 * 65 * 8;
constexpr size_t OFF_BBI = OFF_BBR + (size_t)2048 * 16 * 2;
constexpr size_t OFF_CMT = OFF_BBI + (size_t)2048 * 16 * 2;
constexpr size_t OFF_LB = OFF_CMT + (size_t)32 * 16 * 128 * 2;
constexpr size_t OFF_SSQ = OFF_LB + 2048;
constexpr size_t OFF_BAR = OFF_SSQ + (size_t)NTOK * 4;
constexpr size_t OFF_CNT = OFF_BAR + (size_t)XCD_BAR_WORDS * 4;
constexpr size_t ZERO_BYTES = (size_t)XCD_BAR_WORDS * 4 + 64 * 256;
constexpr size_t OFF_XS = OFF_CNT + 64 * 256;
constexpr size_t WS_END = OFF_XS + (size_t)64 * 256 * 4 * 4;
constexpr size_t O_Y = 0, O_PRE = 17301504, O_PIM = 17317888, O_PHG = 17334272, O_SRE = 17858560, O_SIM = 18120704, O_SHG = 18382848;
constexpr int LDS_BYTES = 131072 + 16;

struct Params { const float* in[21]; float* out; unsigned char* ws; };

DI u16 f2bf(float f) { unsigned r; asm volatile("v_cvt_pk_bf16_f32 %0, %1, %1" : "=v"(r) : "v"(f)); return (u16)(r & 0xffffu); }
DI float bf2f(u16 h) { return __uint_as_float((unsigned)h << 16); }
DI unsigned pk2(float lo, float hi) { unsigned r; asm volatile("v_cvt_pk_bf16_f32 %0, %1, %2" : "=v"(r) : "v"(lo), "v"(hi)); return r; }
DI float wave_sum(float v) {
#pragma unroll
    for (int o = 32; o > 0; o >>= 1) v += __shfl_xor(v, o);
    return v;
}
DI float sigmoidf_(float x) { return 1.0f / (1.0f + __expf(-x)); }
DI float siluf_(float x) { return x / (1.0f + __expf(-x)); }
DI float geluf_(float x) { const float u = 0.7978845608f * (x + 0.044715f * x * x * x); return x / (1.0f + __expf(-2.0f * u)); }
DI void wave_lds_sync() { __builtin_amdgcn_fence(__ATOMIC_RELEASE, "wavefront"); asm volatile("s_waitcnt lgkmcnt(0)" ::: "memory"); __builtin_amdgcn_wave_barrier(); __builtin_amdgcn_fence(__ATOMIC_ACQUIRE, "wavefront"); }

struct TDesc { const float* src; u16* dst; };
DI TDesc transpose_desc(const Params& P, int item, int t) {
    const float* W; u16* Wt; int K, N, tk, tn;
    if (item < 768) { W = P.in[6]; Wt = (u16*)(P.ws + OFF_WIN); K = 1024; N = 3072; tk = item & 15; tn = item >> 4; }
    else if (item < 832) { const int i2 = item - 768; W = P.in[15]; Wt = (u16*)(P.ws + OFF_WGLU); K = 512; N = 512; tk = i2 & 7; tn = i2 >> 3; }
    else { const int i2 = item - 832; W = P.in[19]; Wt = (u16*)(P.ws + OFF_WOUT); K = 1024; N = 1024; tk = i2 & 15; tn = i2 >> 4; }
    TDesc d; d.src = W + (size_t)(tk * 64 + (t >> 3)) * N + tn * 64 + (t & 7) * 8; d.dst = Wt + (size_t)(tn * 64 + (t >> 3)) * K + tk * 64 + (t & 7) * 8; return d;
}

DI void phase_prep(const Params& P, unsigned char* lds) {
    unsigned char* ws = P.ws;
    const int tid = tidx(), lane = tid & 63, wid = tid >> 6;
    { u16* HB = (u16*)(ws + OFF_HB); const float* ng = P.in[5];
      const int gw = blockIdx.x * 8 + wid, nw = gridDim.x * 8;
      f32x4 g4[4], v[4];
#pragma unroll
      for (int i = 0; i < 4; ++i) g4[i] = *(const f32x4*)(ng + i * 256 + lane * 4);
      const int nrow = (nw == 2048) ? (gw >= 1536 ? 9 : 8) : (NTOK - gw + nw - 1) / nw;
      auto rowk = [&](int k) { return (nw == 2048 && k == 8) ? NP + (gw - 1536) : gw + k * nw; };
      if (nrow > 0) { const int r0 = rowk(0); const float* xr = (r0 < NP) ? P.in[0] + (size_t)r0 * 1024 : P.in[1] + (size_t)(r0 - NP) * 1024;
#pragma unroll
          for (int i = 0; i < 4; ++i) v[i] = __builtin_nontemporal_load((const f32x4*)(xr + i * 256 + lane * 4)); }
      for (int k = 0; k < nrow; ++k) {
          const int r = rowk(k), rn = rowk(k + 1 < nrow ? k + 1 : k);
          const float* xn = (rn < NP) ? P.in[0] + (size_t)rn * 1024 : P.in[1] + (size_t)(rn - NP) * 1024;
          f32x4 vn[4];
#pragma unroll
          for (int i = 0; i < 4; ++i) vn[i] = __builtin_nontemporal_load((const f32x4*)(xn + i * 256 + lane * 4));
          float ss = 0.f;
#pragma unroll
          for (int i = 0; i < 4; ++i) ss += v[i][0] * v[i][0] + v[i][1] * v[i][1] + v[i][2] * v[i][2] + v[i][3] * v[i][3];
          ss = wave_sum(ss);
          const float rstd = rsqrtf(ss * (1.0f / 1024.0f) + EPSF);
#pragma unroll
          for (int i = 0; i < 4; ++i) {
              const f32x4 o = v[i] * rstd * g4[i];
              uint2 w; w.x = pk2(o[0], o[1]); w.y = pk2(o[2], o[3]);
              *(uint2*)(HB + (size_t)r * 1024 + i * 256 + lane * 4) = w; v[i] = vn[i]; }
      } }
    { float* tile = (float*)lds;
      int item = blockIdx.x;
      if (item < 1088) {
          TDesc cur = transpose_desc(P, item, tid);
          float4 a = *(const float4*)cur.src, b = *(const float4*)(cur.src + 4);
          for (; item < 1088; item += gridDim.x) {
              const int ni = (item + (int)gridDim.x < 1088) ? item + (int)gridDim.x : item;
              const TDesc nxt = transpose_desc(P, ni, tid);
              const float4 na = *(const float4*)nxt.src, nb = *(const float4*)(nxt.src + 4);
              { float* d = tile + (tid >> 3) * 65 + (tid & 7) * 8; d[0] = a.x; d[1] = a.y; d[2] = a.z; d[3] = a.w; d[4] = b.x; d[5] = b.y; d[6] = b.z; d[7] = b.w; }
              __syncthreads();
              { const int n = tid >> 3, k8 = (tid & 7) * 8; float v[8];
#pragma unroll
                for (int j = 0; j < 8; ++j) v[j] = tile[(k8 + j) * 65 + n];
                u32x4 w; w.x = pk2(v[0], v[1]); w.y = pk2(v[2], v[3]); w.z = pk2(v[4], v[5]); w.w = pk2(v[6], v[7]);
                *(u32x4*)cur.dst = w; }
              __syncthreads();
              a = na; b = nb; cur = nxt;
          }
      } }
    { const int gt = blockIdx.x * NTHR + tid, ngt = gridDim.x * NTHR;
      for (int i = gt; i < 2048 * 65; i += ngt) {
          const int gp = i / 65, j = i - gp * 65, g = gp >> 6;
          const double lr = fmin((double)P.in[7][gp], -1e-4), li = (double)P.in[8][gp], dt = exp((double)P.in[9][g]);
          const double x = li * dt * (double)j; const double n = rint(x * 0.15915494309189535); const double r = x - n * 6.283185307179586;
          const float m = expf((float)(lr * dt * (double)j)), rf = (float)r;
          ((float2*)(ws + OFF_APOW))[i] = make_float2(m * cosf(rf), m * sinf(rf));
      }
      for (int i = gt; i < 2048 * 16; i += ngt) {
          const int gp = i >> 4, c = i & 15, g = gp >> 6, p = gp & 63;
          const double lr = fmin((double)P.in[7][gp], -1e-4), li = (double)P.in[8][gp], dt = exp((double)P.in[9][g]);
          const double x = li * dt; const double n = rint(x * 0.15915494309189535); const double r = x - n * 6.283185307179586;
          const double m = exp(lr * dt); const double are = m * cos(r), aim = m * sin(r);
          const double den = lr * lr + li * li;
          const double zr = ((are - 1.0) * lr + aim * li) / den, zi = (aim * lr - (are - 1.0) * li) / den;
          const double br = (double)P.in[10][i], bi = (double)P.in[11][i];
          ((u16*)(ws + OFF_BBR))[i] = f2bf((float)(zr * br - zi * bi)); ((u16*)(ws + OFF_BBI))[i] = f2bf((float)(zr * bi + zi * br));
          u16* cm = (u16*)(ws + OFF_CMT) + ((size_t)g * 16 + c) * 128;
          cm[2 * p] = f2bf(P.in[12][((size_t)g * 16 + c) * 64 + p]); cm[2 * p + 1] = f2bf(-P.in[13][((size_t)g * 16 + c) * 64 + p]);
      }
      for (int i = gt; i < 512; i += ngt) { const float l0 = P.in[17][i], l1 = P.in[17][512 + i]; ((float*)(ws + OFF_LB))[i] = 1.0f / (1.0f + expf(l1 - l0)); }
      for (int i = gt; i < NTOK; i += ngt) ((float*)(ws + OFF_SSQ))[i] = 0.f;
    }
}

struct EpiProj {
    static constexpr bool PERM = true, AFTER_DRAIN = false;
    unsigned char* ws;
    DI void operator()(const f32x4 (&acc)[2][2][4][2], const pg8::Unit& u, int wr, int wc, int fr, int fq) const {
        const int type = u.pn >> 1;
        const int cbase = (u.pn & 1) * 256 + wc * 32 + 8 * fq;
        const int row0 = u.pm * 256 + wr * 64 + fr;
        if (type == 3) {
            const float* LB = (const float*)(ws + OFF_LB); _Float16* LF = (_Float16*)(ws + OFF_LF);
#pragma unroll
            for (int bj = 0; bj < 2; ++bj) {
                const int col = cbase + bj * 128;
                const f32x4 lb0 = *(const f32x4*)(LB + col), lb1 = *(const f32x4*)(LB + col + 4);
#pragma unroll
                for (int ai = 0; ai < 2; ++ai)
#pragma unroll
                    for (int m = 0; m < 4; ++m) {
                        const size_t row = (size_t)(row0 + ai * 128 + m * 16);
                        f32x4 lf0, lf1;
#pragma unroll
                        for (int j = 0; j < 8; ++j) {
                            float x = (j < 4) ? acc[ai][bj][m][0][j & 3] : acc[ai][bj][m][1][j & 3];
                            const float lb = (j < 4) ? lb0[j & 3] : lb1[j & 3];
                            x = fminf(fmaxf(x, -30.f), 30.f);
                            const float e = __expf(-x), sg = 1.0f / (1.0f + e);
                            const float f = lb + (1.0f - lb) * sg;
                            const float l = __logf(f);
                            if (j < 4) lf0[j & 3] = l; else lf1[j & 3] = l;
                        }
                        *(h16x4*)(LF + row * 512 + col) = __builtin_convertvector(lf0, h16x4); *(h16x4*)(LF + row * 512 + col + 4) = __builtin_convertvector(lf1, h16x4);
                    }
            }
        } else {
            const bool act = (type == 1) || (type == 5);
            u16* O = (u16*)(ws + (type == 0 ? OFF_U : type == 1 ? OFF_SZS : type == 2 ? OFF_Q : type == 4 ? OFF_V : OFF_SZH));
#pragma unroll
            for (int ai = 0; ai < 2; ++ai)
#pragma unroll
                for (int m = 0; m < 4; ++m) {
                    const size_t row = (size_t)(row0 + ai * 128 + m * 16);
#pragma unroll
                    for (int bj = 0; bj < 2; ++bj) {
                        f32x4 v0 = acc[ai][bj][m][0], v1 = acc[ai][bj][m][1];
                        if (act) {
#pragma unroll
                            for (int j = 0; j < 4; ++j) { v0[j] = siluf_(v0[j]); v1[j] = siluf_(v1[j]); }
                        }
                        u32x4 w; w.x = pk2(v0[0], v0[1]); w.y = pk2(v0[2], v0[3]); w.z = pk2(v1[0], v1[1]); w.w = pk2(v1[2], v1[3]);
                        *(u32x4*)(O + row * 512 + cbase + bj * 128) = w;
                    }
                }
        }
    }
};

struct EpiGlu {
    static constexpr bool PERM = true, AFTER_DRAIN = false;
    unsigned char* ws; const float* bglu;
    DI void operator()(const f32x4 (&acc)[2][2][4][2], const pg8::Unit& u, int wr, int wc, int fr, int fq) const {
        const u16* G = (const u16*)(ws + OFF_G); const u16* SZS = (const u16*)(ws + OFF_SZS); u16* CAT = (u16*)(ws + OFF_CAT);
        const int cbase = u.pn * 256 + wc * 32 + 8 * fq;
        const int row0 = u.pm * 256 + wr * 64 + fr;
#pragma unroll
        for (int bj = 0; bj < 2; ++bj) {
            const int col = cbase + bj * 128;
            const f32x4 b0 = *(const f32x4*)(bglu + col), b1 = *(const f32x4*)(bglu + col + 4);
#pragma unroll
            for (int ai = 0; ai < 2; ++ai)
#pragma unroll
                for (int m = 0; m < 4; ++m) {
                    const size_t row = (size_t)(row0 + ai * 128 + m * 16);
                    const u32x4 g8 = *(const u32x4*)(G + row * 512 + col), z8 = *(const u32x4*)(SZS + row * 512 + col);
                    float o[8];
#pragma unroll
                    for (int j = 0; j < 8; ++j) {
                        const float a = ((j < 4) ? acc[ai][bj][m][0][j & 3] : acc[ai][bj][m][1][j & 3]) + ((j < 4) ? b0[j & 3] : b1[j & 3]);
                        const unsigned gw = g8[j >> 1], zw = z8[j >> 1];
                        const float gv = (j & 1) ? __uint_as_float(gw & 0xffff0000u) : __uint_as_float(gw << 16);
                        const float zv = (j & 1) ? __uint_as_float(zw & 0xffff0000u) : __uint_as_float(zw << 16);
                        o[j] = gv * sigmoidf_(a) * zv;
                    }
                    u32x4 w; w.x = pk2(o[0], o[1]); w.y = pk2(o[2], o[3]); w.z = pk2(o[4], o[5]); w.w = pk2(o[6], o[7]);
                    *(u32x4*)(CAT + row * 1024 + col) = w;
                }
        }
    }
};

struct PanelOrder {
    int c;
    __device__ bool next(int i, pg8::Unit& u) const { if (i > 0) return false; u.pm = (c & 7) * 8 + (c >> 5); u.pn = (c >> 3) & 3; return true; }
    DI void a_ready(const pg8::Unit&) const {}
    DI void done(const pg8::Unit&) const {}
};

struct EpiOutNorm {
    static constexpr bool PERM = false, AFTER_DRAIN = true;
    const float* xp; float* out; const float* gfin; float* xs; unsigned* cnt;
    DI void fused(f32x4 (&acc)[2][2][4][2], const pg8::Unit& u, int wr, int wc, int fr, int fq, PG8_LAS unsigned char* lds, int wid, int lane) const {
        PG8_LAS float* Pl = (PG8_LAS float*)lds;
        PG8_LAS float* Sl = (PG8_LAS float*)(lds + 4096);
        const int rl0 = wr * 64 + fr, col0 = u.pn * 256 + wc * 32 + 4 * fq;
#pragma unroll
        for (int ai = 0; ai < 2; ++ai) {
            f32x4 xv[4][2][2];
#pragma unroll
            for (int m = 0; m < 4; ++m)
#pragma unroll
                for (int bj = 0; bj < 2; ++bj)
#pragma unroll
                    for (int n = 0; n < 2; ++n) xv[m][bj][n] = __builtin_nontemporal_load((const f32x4*)(xp + (size_t)(u.pm * 256 + rl0 + ai * 128 + m * 16) * 1024 + col0 + bj * 128 + n * 16));
#pragma unroll
            for (int m = 0; m < 4; ++m) {
                const int rl = rl0 + ai * 128 + m * 16;
                float ss = 0.f;
#pragma unroll
                for (int bj = 0; bj < 2; ++bj)
#pragma unroll
                    for (int n = 0; n < 2; ++n) {
                        const f32x4 r = acc[ai][bj][m][n] + xv[m][bj][n];
                        acc[ai][bj][m][n] = r;
                        ss += r[0] * r[0] + r[1] * r[1] + r[2] * r[2] + r[3] * r[3];
                    }
                ss += __shfl_xor(ss, 16); ss += __shfl_xor(ss, 32);
                if (fq == 0) Pl[rl * 4 + wc] = ss;
            }
        }
        f32x4 g4[2][2];
#pragma unroll
        for (int bj = 0; bj < 2; ++bj)
#pragma unroll
            for (int n = 0; n < 2; ++n) g4[bj][n] = *(const f32x4*)(gfin + col0 + bj * 128 + n * 16);
        __syncthreads();
        const int tid = wid * 64 + lane;
        if (tid < 256) {
            const float t = (Pl[tid * 4 + 0] + Pl[tid * 4 + 1]) + (Pl[tid * 4 + 2] + Pl[tid * 4 + 3]);
            __hip_atomic_store(xs + ((size_t)u.pm * 256 + tid) * 4 + u.pn, t, __ATOMIC_RELAXED, __HIP_MEMORY_SCOPE_AGENT);
        }
        asm volatile("s_waitcnt vmcnt(0)" ::: "memory");
        __syncthreads();
        if (tid == 0) {
            unsigned* c = cnt + (size_t)u.pm * 64;
            __hip_atomic_fetch_add(c, 1u, __ATOMIC_RELAXED, __HIP_MEMORY_SCOPE_AGENT);
            unsigned sp = 0;
            while (__hip_atomic_load(c, __ATOMIC_RELAXED, __HIP_MEMORY_SCOPE_AGENT) < 4u) { __builtin_amdgcn_s_sleep(1); if (++sp > (1u << 22)) break; }
        }
        __syncthreads();
        if (tid < 256) {
            const float* p = xs + ((size_t)u.pm * 256 + tid) * 4;
            const float t = (__hip_atomic_load(p, __ATOMIC_RELAXED, __HIP_MEMORY_SCOPE_AGENT) + __hip_atomic_load(p + 1, __ATOMIC_RELAXED, __HIP_MEMORY_SCOPE_AGENT))
                          + (__hip_atomic_load(p + 2, __ATOMIC_RELAXED, __HIP_MEMORY_SCOPE_AGENT) + __hip_atomic_load(p + 3, __ATOMIC_RELAXED, __HIP_MEMORY_SCOPE_AGENT));
            Sl[tid] = rsqrtf(t * (1.0f / 1024.0f) + EPSF);
        }
        __syncthreads();
#pragma unroll
        for (int ai = 0; ai < 2; ++ai)
#pragma unroll
            for (int m = 0; m < 4; ++m) {
                const int rl = rl0 + ai * 128 + m * 16;
                const float rstd = Sl[rl];
                float* orow = out + (size_t)(u.pm * 256 + rl) * 1024 + col0;
#pragma unroll
                for (int bj = 0; bj < 2; ++bj)
#pragma unroll
                    for (int n = 0; n < 2; ++n) __builtin_nontemporal_store(acc[ai][bj][m][n] * rstd * g4[bj][n], (f32x4*)(orow + bj * 128 + n * 16));
            }
        __syncthreads();
    }
};

template <int NST, class F>
DI void small_gemm_tile(const u16* __restrict__ A, int lda, const u16* __restrict__ Bt, int ldb, int row0, int col0, unsigned char* lds, F&& epi) {
    const int tid = tidx(), lane = tid & 63, wid = __builtin_amdgcn_readfirstlane(tid >> 6), fr = lane & 15, fq = lane >> 4;
    const int koff = wid * (NST * 32) + fq * (NST * 8);
    bf16x8 af[4][NST], bfv[4][NST];
#pragma unroll
    for (int t = 0; t < 4; ++t)
#pragma unroll
        for (int j = 0; j < NST; ++j) {
            af[t][j] = *(const bf16x8*)(A + (size_t)(row0 + t * 16 + fr) * lda + koff + 8 * j);
            bfv[t][j] = *(const bf16x8*)(Bt + (size_t)(col0 + t * 16 + fr) * ldb + koff + 8 * j);
        }
    f32x4 acc[4][4];
#pragma unroll
    for (int m = 0; m < 4; ++m)
#pragma unroll
        for (int n = 0; n < 4; ++n) acc[m][n] = (f32x4){0.f, 0.f, 0.f, 0.f};
#pragma unroll
    for (int j = 0; j < NST; ++j)
#pragma unroll
        for (int m = 0; m < 4; ++m)
#pragma unroll
            for (int n = 0; n < 4; ++n) acc[m][n] = MFMA16(bfv[n][j], af[m][j], acc[m][n]);
    f32x4* Pw = (f32x4*)lds;
#pragma unroll
    for (int m = 0; m < 4; ++m)
#pragma unroll
        for (int n = 0; n < 4; ++n) Pw[(wid * 64 + m * 16 + fr) * 16 + ((n * 4 + fq) ^ fr)] = acc[m][n];
    __syncthreads();
    { const int row = tid >> 3;
#pragma unroll
      for (int h = 0; h < 2; ++h) {
          const int slot = (tid & 7) * 2 + h;
          f32x4 v = {0.f, 0.f, 0.f, 0.f};
#pragma unroll
          for (int w = 0; w < 8; ++w) v += Pw[(w * 64 + row) * 16 + (slot ^ (row & 15))];
          epi(row0 + row, col0 + slot * 4, v);
      } }
    __syncthreads();
}

DI void proj_store4(unsigned char* ws, int row, int col, f32x4 v) {
    const int type = col >> 9, cc = col & 511; const size_t o = (size_t)row * 512 + cc;
    if (type == 3) {
        const f32x4 lb = *(const f32x4*)((const float*)(ws + OFF_LB) + cc);
        f32x4 lf;
#pragma unroll
        for (int j = 0; j < 4; ++j) { const float x = fminf(fmaxf(v[j], -30.f), 30.f); const float e = __expf(-x), sg = 1.0f / (1.0f + e); lf[j] = __logf(lb[j] + (1.0f - lb[j]) * sg); }
        *(h16x4*)((_Float16*)(ws + OFF_LF) + o) = __builtin_convertvector(lf, h16x4);
    } else {
        if (type == 1 || type == 5) {
#pragma unroll
            for (int j = 0; j < 4; ++j) v[j] = siluf_(v[j]);
        }
        u16* O = (u16*)(ws + (type == 0 ? OFF_U : type == 1 ? OFF_SZS : type == 2 ? OFF_Q : type == 4 ? OFF_V : OFF_SZH));
        uint2 w; w.x = pk2(v[0], v[1]); w.y = pk2(v[2], v[3]); *(uint2*)(O + o) = w;
    }
}

DI void s5_pass1(const Params& P) {
    unsigned char* ws = P.ws;
    const int tid = tidx(), lane = tid & 63, wid = tid >> 6, gw = blockIdx.x * 8 + wid, nw = gridDim.x * 8;
    const int n = lane & 31, h = lane >> 5;
    const u16* U = (const u16*)(ws + OFF_U); const u16* BBR = (const u16*)(ws + OFF_BBR); const u16* BBI = (const u16*)(ws + OFF_BBI);
    const float2* APOW = (const float2*)(ws + OFF_APOW); float2* HEND = (float2*)(ws + OFF_HEND);
    const int gh = gw & 63, g = gh >> 1, half = gh & 1, p = half * 32 + n;
    const bf16x8 bre = *(const bf16x8*)(BBR + (size_t)(g * 64 + p) * 16 + 8 * h), bim = *(const bf16x8*)(BBI + (size_t)(g * 64 + p) * 16 + 8 * h);
    const float2* ap = APOW + (size_t)(g * 64 + p) * 65;
    float2 w[16];
#pragma unroll
    for (int i = 0; i < 16; ++i) w[i] = ap[31 - ((i & 3) + 8 * (i >> 2) + 4 * h)];
    const float2 a32 = ap[32];
    const int step = nw >> 6;
    int bc = gw >> 6;
    const u16* ub = U + (size_t)n * 512 + g * 16 + 8 * h;
    bf16x8 a0, a1;
    if (bc < 256) { const int tok0 = (bc >> 5) * 2048 + (bc & 31) * 64; a0 = *(const bf16x8*)(ub + (size_t)tok0 * 512); a1 = *(const bf16x8*)(ub + (size_t)(tok0 + 32) * 512); }
    for (; bc < 256; bc += step) {
        const int bn = (bc + step < 256) ? bc + step : bc;
        const int tokn = (bn >> 5) * 2048 + (bn & 31) * 64;
        const bf16x8 n0 = *(const bf16x8*)(ub + (size_t)tokn * 512), n1 = *(const bf16x8*)(ub + (size_t)(tokn + 32) * 512);
        f32x16 z; for (int i = 0; i < 16; ++i) z[i] = 0.f;
        const f32x16 cr0 = MFMA32(a0, bre, z), ci0 = MFMA32(a0, bim, z), cr1 = MFMA32(a1, bre, z), ci1 = MFMA32(a1, bim, z);
        float e0r = 0.f, e0i = 0.f, e1r = 0.f, e1i = 0.f;
#pragma unroll
        for (int i = 0; i < 16; ++i) {
            e1r += w[i].x * cr1[i] - w[i].y * ci1[i]; e1i += w[i].x * ci1[i] + w[i].y * cr1[i];
            e0r += w[i].x * cr0[i] - w[i].y * ci0[i]; e0i += w[i].x * ci0[i] + w[i].y * cr0[i];
        }
        float tr = e1r + a32.x * e0r - a32.y * e0i, ti = e1i + a32.x * e0i + a32.y * e0r;
        tr += __shfl_xor(tr, 32); ti += __shfl_xor(ti, 32);
        if (h == 0) HEND[(size_t)bc * 2048 + g * 64 + p] = make_float2(tr, ti);
        a0 = n0; a1 = n1;
    }
}

DI void s5_sample(const Params& P, unsigned char* lds) {
    unsigned char* ws = P.ws;
    const int tid = tidx(), lane = tid & 63, wid = tid >> 6, gw = blockIdx.x * 8 + wid, nw = gridDim.x * 8;
    float* Hw = (float*)lds + wid * 512;
    const u16* U = (const u16*)(ws + OFF_U); const u16* BBR = (const u16*)(ws + OFF_BBR); const u16* BBI = (const u16*)(ws + OFF_BBI);
    const float2* APOW = (const float2*)(ws + OFF_APOW); u16* G = (u16*)(ws + OFF_G);
    const int c = lane & 15, qd = lane >> 4, g = gw & 31, p = lane, step = nw >> 5;
    const float2 A = APOW[(size_t)(g * 64 + p) * 65 + 1];
    const u32x4 br0 = *(const u32x4*)(BBR + (size_t)(g * 64 + p) * 16), br1 = *(const u32x4*)(BBR + (size_t)(g * 64 + p) * 16 + 8);
    const u32x4 bi0 = *(const u32x4*)(BBI + (size_t)(g * 64 + p) * 16), bi1 = *(const u32x4*)(BBI + (size_t)(g * 64 + p) * 16 + 8);
    f32x4 crv[4], civ[4];
    { const float* cre = P.in[12] + ((size_t)g * 16 + c) * 64 + qd * 16; const float* cim = P.in[13] + ((size_t)g * 16 + c) * 64 + qd * 16;
#pragma unroll
      for (int i = 0; i < 4; ++i) { crv[i] = *(const f32x4*)(cre + 4 * i); civ[i] = *(const f32x4*)(cim + 4 * i); } }
    const float dd = P.in[14][g * 16 + c];
    int bs = gw >> 5;
    float chr = 0.f, chi = 0.f; u32x4 cu[8]; unsigned cud[4];
    if (bs < 128) {
        chr = P.in[2][(size_t)(bs * 32 + g) * 64 + p]; chi = P.in[3][(size_t)(bs * 32 + g) * 64 + p];
#pragma unroll
        for (int t = 0; t < 4; ++t) { const u16* ur = U + (size_t)(NP + bs * 4 + t) * 512 + g * 16; cu[2 * t] = *(const u32x4*)ur; cu[2 * t + 1] = *(const u32x4*)(ur + 8); cud[t] = ur[c]; }
    }
    for (; bs < 128; bs += step) {
        const int nb = (bs + step < 128) ? bs + step : bs;
        const float nhr = P.in[2][(size_t)(nb * 32 + g) * 64 + p], nhi = P.in[3][(size_t)(nb * 32 + g) * 64 + p];
        u32x4 nu[8]; unsigned nud[4];
#pragma unroll
        for (int t = 0; t < 4; ++t) { const u16* ur = U + (size_t)(NP + nb * 4 + t) * 512 + g * 16; nu[2 * t] = *(const u32x4*)ur; nu[2 * t + 1] = *(const u32x4*)(ur + 8); nud[t] = ur[c]; }
        float hr = chr, hi = chi;
#pragma unroll
        for (int t = 0; t < 4; ++t) {
            const u32x4 u0 = cu[2 * t], u1 = cu[2 * t + 1];
            float bur = 0.f, bui = 0.f;
#pragma unroll
            for (int k = 0; k < 8; ++k) {
                const unsigned uw = (k < 4) ? u0[k & 3] : u1[k & 3];
                const unsigned rw = (k < 4) ? br0[k & 3] : br1[k & 3];
                const unsigned iw = (k < 4) ? bi0[k & 3] : bi1[k & 3];
                const float ul = __uint_as_float(uw << 16), uh = __uint_as_float(uw & 0xffff0000u);
                bur += __uint_as_float(rw << 16) * ul + __uint_as_float(rw & 0xffff0000u) * uh;
                bui += __uint_as_float(iw << 16) * ul + __uint_as_float(iw & 0xffff0000u) * uh;
            }
            const float nr = A.x * hr - A.y * hi + bur, ni = A.x * hi + A.y * hr + bui;
            hr = nr; hi = ni;
            Hw[t * 128 + p] = hr; Hw[t * 128 + 64 + p] = hi;
        }
        P.out[O_SRE + (size_t)(bs * 32 + g) * 64 + p] = hr; P.out[O_SIM + (size_t)(bs * 32 + g) * 64 + p] = hi;
        wave_lds_sync();
#pragma unroll
        for (int t = 0; t < 4; ++t) {
            float a = 0.f;
#pragma unroll
            for (int i = 0; i < 16; ++i) a += crv[i >> 2][i & 3] * Hw[t * 128 + qd * 16 + i] - civ[i >> 2][i & 3] * Hw[t * 128 + 64 + qd * 16 + i];
            a += __shfl_xor(a, 16); a += __shfl_xor(a, 32);
            const size_t tok = (size_t)(NP + bs * 4 + t);
            const float y = a + dd * __uint_as_float(cud[t] << 16);
            if (qd == 0) G[tok * 512 + g * 16 + c] = f2bf(geluf_(y));
        }
        wave_lds_sync();
        chr = nhr; chi = nhi;
#pragma unroll
        for (int i = 0; i < 8; ++i) cu[i] = nu[i];
#pragma unroll
        for (int t = 0; t < 4; ++t) cud[t] = nud[t];
    }
}

struct HCols { float lf[16]; unsigned vq[16]; };
template <bool PASS2>
DI void hgrn_load_cols(const Params& P, int unit, HCols& r) {
    const unsigned char* ws = P.ws;
    const int col = tidx() & 127, segu = __builtin_amdgcn_readfirstlane((int)(tidx() >> 7));
    const int b = unit >> 7, hh = (unit >> 5) & 3, chunk = unit & 31;
    const size_t rb = (size_t)(b * 2048 + chunk * 64 + segu * 16) * 512 + hh * 128;
    const _Float16* lfp = (const _Float16*)(ws + OFF_LF) + rb; const u16* vp = (const u16*)(ws + OFF_V) + rb; const u16* qp = (const u16*)(ws + OFF_Q) + rb;
#pragma unroll
    for (int i = 0; i < 16; ++i) { r.lf[i] = (float)lfp[(size_t)i * 512 + col]; const unsigned v = vp[(size_t)i * 512 + col]; const unsigned q = PASS2 ? (unsigned)qp[(size_t)i * 512 + col] : 0u; r.vq[i] = v | (q << 16); }
}
template <bool PASS2>
DI void hgrn_unit(const Params& P, unsigned char* lds, int unit, const HCols& cur, int next_unit, HCols& nxt) {
    unsigned char* ws = P.ws;
    const int tid = tidx(), lane = tid & 63, wid = __builtin_amdgcn_readfirstlane(tid >> 6), fr = lane & 15, fq = lane >> 4;
    const int b = unit >> 7, hh = (unit >> 5) & 3, chunk = unit & 31;
    const int tokc = b * 2048 + chunk * 64;
    u16* Qt = (u16*)lds;
    u16* Kt = PASS2 ? (u16*)(lds + 17408) : (u16*)lds;
    u16* VT = (u16*)(lds + 34816);
    float* SEG = (float*)(lds + 53248);
    float* SS = (float*)(lds + 55296);
    const u16* SSTu = (const u16*)(ws + OFF_HB) + (size_t)unit * 16384;
    const int tt = wid & 3, vh = wid >> 2;
    bf16x8 asf[4][4]; f32x4 g4e[4]; uint2 ze[4];
    if (PASS2) {
#pragma unroll
        for (int vl = 0; vl < 4; ++vl) { const int v0 = hh * 128 + (vh * 4 + vl) * 16 + 4 * fq; g4e[vl] = *(const f32x4*)(P.in[18] + v0); ze[vl] = *(const uint2*)((const u16*)(ws + OFF_SZH) + (size_t)(tokc + tt * 16 + fr) * 512 + v0); }
#pragma unroll
        for (int vl = 0; vl < 4; ++vl)
#pragma unroll
            for (int ks = 0; ks < 4; ++ks) asf[vl][ks] = *(const bf16x8*)((SSTu + (size_t)(vh * 4 + vl) * 2048 + ks * 32) + (fr * 128 + fq * 8));
    }
    {
        const int col = tid & 127, seg = tid >> 7;
        float c[16], kf[16]; u16 vv[16], qq[16];
#pragma unroll
        for (int i = 0; i < 16; ++i) { c[i] = cur.lf[i]; vv[i] = (u16)(cur.vq[i] & 0xffffu); qq[i] = (u16)(cur.vq[i] >> 16); }
#pragma unroll
        for (int i = 0; i < 16; ++i) kf[i] = 1.0f - __expf(c[i]);
#pragma unroll
        for (int i = 1; i < 16; ++i) c[i] += c[i - 1];
        SEG[seg * 128 + col] = c[15];
        __syncthreads();
        float pre = 0.f, tot = 0.f;
#pragma unroll
        for (int s = 0; s < 4; ++s) { const float v = SEG[s * 128 + col]; tot += v; if (s < seg) pre += v; }
        u32x4 v0, v1;
        v0.x = (unsigned)vv[0] | ((unsigned)vv[1] << 16); v0.y = (unsigned)vv[2] | ((unsigned)vv[3] << 16); v0.z = (unsigned)vv[4] | ((unsigned)vv[5] << 16); v0.w = (unsigned)vv[6] | ((unsigned)vv[7] << 16);
        v1.x = (unsigned)vv[8] | ((unsigned)vv[9] << 16); v1.y = (unsigned)vv[10] | ((unsigned)vv[11] << 16); v1.z = (unsigned)vv[12] | ((unsigned)vv[13] << 16); v1.w = (unsigned)vv[14] | ((unsigned)vv[15] << 16);
        *(u32x4*)(VT + col * 72 + seg * 16) = v0; *(u32x4*)(VT + col * 72 + seg * 16 + 8) = v1;
        if (PASS2) {
#pragma unroll
            for (int i = 0; i < 16; ++i) {
                const float bb = pre + c[i];
                Qt[(seg * 16 + i) * 136 + col] = f2bf(bf2f(qq[i]) * __expf(bb));
                Kt[(seg * 16 + i) * 136 + col] = f2bf(kf[i] * __expf(-bb));
            }
        } else {
            float kh[16];
#pragma unroll
            for (int i = 0; i < 16; ++i) kh[i] = kf[i] * __expf(tot - (pre + c[i]));
            u32x4 k0, k1;
            k0.x = pk2(kh[0], kh[1]); k0.y = pk2(kh[2], kh[3]); k0.z = pk2(kh[4], kh[5]); k0.w = pk2(kh[6], kh[7]);
            k1.x = pk2(kh[8], kh[9]); k1.y = pk2(kh[10], kh[11]); k1.z = pk2(kh[12], kh[13]); k1.w = pk2(kh[14], kh[15]);
            *(u32x4*)(Kt + col * 72 + seg * 16) = k0; *(u32x4*)(Kt + col * 72 + seg * 16 + 8) = k1;
            if (seg == 0) ((float*)(ws + OFF_DEC))[(size_t)unit * 128 + col] = __expf(tot);
        }
        __syncthreads();
    }
    hgrn_load_cols<PASS2>(P, next_unit, nxt);
    if (!PASS2) {
        _Float16* SLOC = (_Float16*)(P.out + O_Y) + (size_t)unit * 16384;
        const int kt = wid;
        const bf16x8 a0 = *(const bf16x8*)(Kt + (kt * 16 + fr) * 72 + fq * 8), a1 = *(const bf16x8*)(Kt + (kt * 16 + fr) * 72 + 32 + fq * 8);
#pragma unroll
        for (int vt = 0; vt < 8; ++vt) {
            f32x4 acc = {0.f, 0.f, 0.f, 0.f};
            const bf16x8 b0 = *(const bf16x8*)(VT + (vt * 16 + fr) * 72 + fq * 8), b1 = *(const bf16x8*)(VT + (vt * 16 + fr) * 72 + 32 + fq * 8);
            acc = MFMA16(a0, b0, acc); acc = MFMA16(a1, b1, acc);
            *(h16x4*)(SLOC + (size_t)(vt * 16 + fr) * 128 + kt * 16 + 4 * fq) = __builtin_convertvector(acc, h16x4);
        }
    } else {
        bf16x8 bq[4];
#pragma unroll
        for (int ks = 0; ks < 4; ++ks) bq[ks] = *(const bf16x8*)(Qt + (tt * 16 + fr) * 136 + ks * 32 + fq * 8);
        float pv[4][4];
#pragma unroll
        for (int st = 0; st < 4; ++st) {
            f32x4 pa = {0.f, 0.f, 0.f, 0.f};
#pragma unroll
            for (int ks = 0; ks < 4; ++ks) { const bf16x8 ak = *(const bf16x8*)(Kt + (st * 16 + fr) * 136 + ks * 32 + fq * 8); pa = MFMA16(ak, bq[ks], pa); }
#pragma unroll
            for (int j = 0; j < 4; ++j) pv[st][j] = ((st * 16 + 4 * fq + j) <= (tt * 16 + fr)) ? pa[j] : 0.f;
        }
        bf16x8 pf[2];
#pragma unroll
        for (int k2 = 0; k2 < 2; ++k2) {
            u32x4 w; w.x = pk2(pv[2 * k2][0], pv[2 * k2][1]); w.y = pk2(pv[2 * k2][2], pv[2 * k2][3]); w.z = pk2(pv[2 * k2 + 1][0], pv[2 * k2 + 1][1]); w.w = pk2(pv[2 * k2 + 1][2], pv[2 * k2 + 1][3]);
            pf[k2] = __builtin_bit_cast(bf16x8, w);
        }
        f32x4 oacc[4]; float ssq = 0.f;
#pragma unroll
        for (int vl = 0; vl < 4; ++vl) {
            const int vt = vh * 4 + vl;
            f32x4 o = {0.f, 0.f, 0.f, 0.f};
#pragma unroll
            for (int k2 = 0; k2 < 2; ++k2) {
                const s16x4 lo = *(const s16x4*)(VT + (vt * 16 + fr) * 72 + 32 * k2 + 4 * fq), hi = *(const s16x4*)(VT + (vt * 16 + fr) * 72 + 32 * k2 + 16 + 4 * fq);
                const bf16x8 av = __builtin_shufflevector(lo, hi, 0, 1, 2, 3, 4, 5, 6, 7);
                o = MFMA16(av, pf[k2], o);
            }
#pragma unroll
            for (int ks = 0; ks < 4; ++ks) o = MFMA16(asf[vl][ks], bq[ks], o);
            oacc[vl] = o; ssq += o[0] * o[0] + o[1] * o[1] + o[2] * o[2] + o[3] * o[3];
        }
        ssq += __shfl_xor(ssq, 16); ssq += __shfl_xor(ssq, 32);
        if (fq == 0) SS[vh * 64 + tt * 16 + fr] = ssq;
        __syncthreads();
        const float rstd = rsqrtf((SS[tt * 16 + fr] + SS[64 + tt * 16 + fr]) * (1.0f / 128.0f) + EPSF);
        const size_t tok = (size_t)(tokc + tt * 16 + fr);
        u16* CAT = (u16*)(ws + OFF_CAT);
#pragma unroll
        for (int vl = 0; vl < 4; ++vl) {
            const int v0 = hh * 128 + (vh * 4 + vl) * 16 + 4 * fq;
            const f32x4 g4 = g4e[vl];
            const uint2 z = ze[vl];
            uint2 w;
            w.x = pk2(oacc[vl][0] * rstd * g4[0] * __uint_as_float(z.x << 16), oacc[vl][1] * rstd * g4[1] * __uint_as_float(z.x & 0xffff0000u));
            w.y = pk2(oacc[vl][2] * rstd * g4[2] * __uint_as_float(z.y << 16), oacc[vl][3] * rstd * g4[3] * __uint_as_float(z.y & 0xffff0000u));
            *(uint2*)(CAT + tok * 1024 + 512 + v0) = w;
        }
    }
    __syncthreads();
}

DI void hgrn_sample_load(const Params& P, int task, f32x4 (&s0v)[8]) {
    const int tid = tidx();
    const float* S0 = P.in[4] + (size_t)task * 16384 + (size_t)((tid >> 5) * 8) * 128 + 4 * (tid & 31);
#pragma unroll
    for (int i = 0; i < 8; ++i) s0v[i] = __builtin_nontemporal_load((const f32x4*)(S0 + (size_t)i * 128));
}
DI void hgrn_sample(const Params& P, unsigned char* lds, int task, const f32x4 (&s0v)[8], int next_task, f32x4 (&s0n)[8]) {
    unsigned char* ws = P.ws;
    const int tid = tidx(), lane = tid & 63, wid = tid >> 6;
    const int bs = task >> 2, hh = task & 3;
    float* QE = (float*)lds;
    float* KH = QE + 512;
    float* EB3 = KH + 512;
    float* VV = EB3 + 128;
    float* RED = VV + 512;
    float* RED2 = RED + 32;
    float* OP = RED2 + 32;
    const size_t tokb = (size_t)(NP + bs * 4);
    const float zfin = bf2f(((const u16*)(ws + OFF_SZH))[(tokb + (tid >> 7)) * 512 + hh * 128 + (tid & 127)]);
    const float gfin_ = P.in[18][hh * 128 + (tid & 127)];
    if (next_task != task) hgrn_sample_load(P, next_task, s0n);
    if (tid < 128) {
        const int k = tid; float lf[4], q[4], kk[4], bb[4];
#pragma unroll
        for (int t = 0; t < 4; ++t) { const size_t o = (tokb + t) * 512 + hh * 128 + k; lf[t] = (float)((const _Float16*)(ws + OFF_LF))[o]; q[t] = bf2f(((const u16*)(ws + OFF_Q))[o]); kk[t] = 1.0f - __expf(lf[t]); }
        bb[0] = lf[0]; bb[1] = bb[0] + lf[1]; bb[2] = bb[1] + lf[2]; bb[3] = bb[2] + lf[3];
#pragma unroll
        for (int t = 0; t < 4; ++t) { QE[t * 128 + k] = q[t] * __expf(bb[t]); KH[t * 128 + k] = kk[t] * __expf(bb[3] - bb[t]); }
        EB3[k] = __expf(bb[3]);
        int idx = 0;
#pragma unroll
        for (int t = 0; t < 4; ++t)
#pragma unroll
            for (int s = 0; s <= t; ++s) { float pr = q[t] * kk[s] * __expf(bb[t] - bb[s]); pr = wave_sum(pr); if (lane == 0) RED[wid * 16 + idx] = pr; ++idx; }
    } else if (tid < 256) {
        const int v = tid - 128;
#pragma unroll
        for (int s = 0; s < 4; ++s) VV[s * 128 + v] = bf2f(((const u16*)(ws + OFF_V))[(tokb + s) * 512 + hh * 128 + v]);
    }
    __syncthreads();
    {
        const int v4 = tid & 31, kg = tid >> 5;
        const float* S0 = P.in[4] + (size_t)(bs * 4 + hh) * 16384; float* SN = P.out + O_SHG + (size_t)(bs * 4 + hh) * 16384;
        f32x4 op[4]; for (int t = 0; t < 4; ++t) op[t] = (f32x4){0.f, 0.f, 0.f, 0.f};
        f32x4 vs[4]; for (int s = 0; s < 4; ++s) vs[s] = *(const f32x4*)(VV + s * 128 + 4 * v4);
#pragma unroll
        for (int i = 0; i < 8; ++i) {
            const int k = kg * 8 + i;
            const f32x4 s4 = s0v[i];
            f32x4 sn = s4 * EB3[k];
#pragma unroll
            for (int t = 0; t < 4; ++t) { op[t] += s4 * QE[t * 128 + k]; sn += vs[t] * KH[t * 128 + k]; }
            __builtin_nontemporal_store(sn, (f32x4*)(SN + (size_t)k * 128 + 4 * v4));
        }
#pragma unroll
        for (int t = 0; t < 4; ++t) *(f32x4*)(OP + (kg * 4 + t) * 128 + 4 * v4) = op[t];
    }
    __syncthreads();
    {
        const int t = tid >> 7, v = tid & 127;
        float o = 0.f;
#pragma unroll
        for (int kg = 0; kg < 16; ++kg) o += OP[(kg * 4 + t) * 128 + v];
        const int tb = (t * (t + 1)) >> 1;
        for (int s = 0; s <= t; ++s) o += (RED[tb + s] + RED[16 + tb + s]) * VV[s * 128 + v];
        const float ss = wave_sum(o * o);
        if (lane == 0) RED2[wid] = ss;
        __syncthreads();
        const float rstd = rsqrtf((RED2[2 * t] + RED2[2 * t + 1]) * (1.0f / 128.0f) + EPSF);
        const size_t tok = tokb + t;
        ((u16*)(ws + OFF_CAT))[tok * 1024 + 512 + hh * 128 + v] = f2bf(o * rstd * gfin_ * zfin);
    }
    __syncthreads();
}

DI void phase_scan(const Params& P) {
    unsigned char* ws = P.ws;
    const int gt = blockIdx.x * NTHR + tidx(), ngt = gridDim.x * NTHR;
    { const _Float16* SLOC = (const _Float16*)(P.out + O_Y); const float* DEC = (const float*)(ws + OFF_DEC); u16* SST = (u16*)(ws + OFF_HB);
      for (int idx = gt; idx < 131072; idx += ngt) {
          const int bh = idx >> 12, rem = idx & 4095, v = rem >> 5, k4 = rem & 31;
          f32x4 S = {0.f, 0.f, 0.f, 0.f};
          for (int c0 = 0; c0 < 32; c0 += 8) {
              f32x4 sl[8], d[8];
#pragma unroll
              for (int c = 0; c < 8; ++c) { const size_t unit = (size_t)bh * 32 + c0 + c;
                  sl[c] = __builtin_convertvector(*(const h16x4*)(SLOC + (unit * 128 + v) * 128 + 4 * k4), f32x4); d[c] = *(const f32x4*)(DEC + unit * 128 + 4 * k4); }
#pragma unroll
              for (int c = 0; c < 8; ++c) { const size_t unit = (size_t)bh * 32 + c0 + c;
                  uint2 w; w.x = pk2(S[0], S[1]); w.y = pk2(S[2], S[3]);
                  *(uint2*)(SST + (unit * 128 + v) * 128 + 4 * k4) = w;
                  S = d[c] * S + sl[c]; }
          }
#pragma unroll
          for (int j = 0; j < 4; ++j) P.out[O_PHG + ((size_t)bh * 128 + 4 * k4 + j) * 128 + v] = S[j];
      } }
}

template <bool FUSE>
DI void s5_pass2(const Params& P, unsigned char* lds) {
    unsigned char* ws = P.ws;
    const int tid = tidx(), lane = tid & 63, wid = tid >> 6, gw = blockIdx.x * 8 + wid, nw = gridDim.x * 8, fr = lane & 15, fq = lane >> 4;
    float* BUw = (float*)(lds + wid * 12800);
    unsigned char* Hw = lds + wid * 12800 + 8448;
    const u16* U = (const u16*)(ws + OFF_U); const u16* BBR = (const u16*)(ws + OFF_BBR); const u16* BBI = (const u16*)(ws + OFF_BBI); const u16* CMT = (const u16*)(ws + OFF_CMT);
    const float2* APOW = (const float2*)(ws + OFF_APOW); u16* G = (u16*)(ws + OFF_G);
    const bf16x8 zero8 = {0, 0, 0, 0, 0, 0, 0, 0};
    const float2* HEND = (const float2*)(ws + OFF_HEND);
    const int sidx = blockIdx.x * NTHR + tid, sbh = sidx >> 12, sv = (sidx & 4095) >> 5, sk4 = sidx & 31;
    const _Float16* slp = (const _Float16*)(P.out + O_Y) + ((size_t)sbh * 32 * 128 + sv) * 128 + 4 * sk4;
    const float* dcp = (const float*)(ws + OFF_DEC) + (size_t)sbh * 32 * 128 + 4 * sk4;
    u16* stp = (u16*)(ws + OFF_HB) + ((size_t)sbh * 32 * 128 + sv) * 128 + 4 * sk4;
    f32x4 S = {0.f, 0.f, 0.f, 0.f};
    h16x4 csl[2], nsl[2]; f32x4 cd[2], nd[2];
    if (FUSE) {
#pragma unroll
        for (int c = 0; c < 2; ++c) { csl[c] = *(const h16x4*)(slp + (size_t)c * 16384); cd[c] = *(const f32x4*)(dcp + (size_t)c * 128); }
    }
    for (int T = gw; T < 2048; T += nw) {
        const bool scan_here = FUSE && (T == gw);
        const int g = T & 31, br = T >> 5, b = br >> 3, run = br & 7, p = lane;
        const float2 A = APOW[(size_t)(g * 64 + p) * 65 + 1];
        const float2 a64 = APOW[(size_t)(g * 64 + p) * 65 + 64];
        float hr = 0.f, hi = 0.f;
        { float2 e[28];
#pragma unroll
          for (int c2 = 0; c2 < 28; ++c2) if (c2 < 4 * run) e[c2] = HEND[(size_t)(b * 32 + c2) * 2048 + g * 64 + p];
#pragma unroll
          for (int c2 = 0; c2 < 28; ++c2) if (c2 < 4 * run) { const float nr = a64.x * hr - a64.y * hi + e[c2].x, ni = a64.x * hi + a64.y * hr + e[c2].y; hr = nr; hi = ni; } }
        bf16x8 bfr[8], cfr[4];
#pragma unroll
        for (int nt = 0; nt < 8; ++nt) { const u16* src = ((nt & 1) ? BBI : BBR) + (size_t)(g * 64 + (nt >> 1) * 16 + fr) * 16 + 8 * (fq & 1); bfr[nt] = (fq < 2) ? *(const bf16x8*)src : zero8; }
#pragma unroll
        for (int ks = 0; ks < 4; ++ks) cfr[ks] = *(const bf16x8*)(CMT + (size_t)(g * 16 + fr) * 128 + ks * 32 + fq * 8);
        bf16x8 dfr;
        { const short dbits = (short)f2bf(P.in[14][g * 16 + fr]);
#pragma unroll
          for (int j = 0; j < 8; ++j) dfr[j] = (fq < 2 && 8 * fq + j == fr) ? dbits : (short)0; }
        const int cre_col = (p >> 4) * 32 + (p & 15);
        const int tok0 = b * 2048 + run * 256;
        const u16* up = U + (size_t)(tok0 + fr) * 512 + g * 16 + 8 * (fq & 1);
        bf16x8 a = (fq < 2) ? *(const bf16x8*)up : zero8;
        bf16x8 a1 = (fq < 2) ? *(const bf16x8*)(up + (size_t)16 * 512) : zero8;
#define S5_BU(AOP) do { _Pragma("unroll") for (int nt = 0; nt < 8; ++nt) { f32x4 c_ = {0.f, 0.f, 0.f, 0.f}; c_ = MFMA16((AOP), bfr[nt], c_); \
            _Pragma("unroll") for (int j = 0; j < 4; ++j) BUw[(4 * fq + j) * 132 + nt * 16 + fr] = c_[j]; } } while (0)
        S5_BU(a);
        wave_lds_sync();
        for (int tt = 0; tt < 16; ++tt) {
            const int tokb = tok0 + tt * 16;
            const bf16x8 a2 = (fq < 2) ? *(const bf16x8*)(up + (size_t)((tt < 14 ? tt + 2 : 15) * 16) * 512) : zero8;
            if (scan_here) {
                const int cn = tt < 15 ? 2 * tt + 2 : 30;
#pragma unroll
                for (int c = 0; c < 2; ++c) { nsl[c] = *(const h16x4*)(slp + (size_t)(cn + c) * 16384); nd[c] = *(const f32x4*)(dcp + (size_t)(cn + c) * 128); }
            }
#pragma unroll
            for (int t = 0; t < 16; ++t) {
                const float bur = BUw[t * 132 + cre_col], bui = BUw[t * 132 + cre_col + 16];
                const float nr = A.x * hr - A.y * hi + bur, ni = A.x * hi + A.y * hr + bui;
                hr = nr; hi = ni;
                *(unsigned*)(Hw + t * 272 + 4 * p) = pk2(hr, hi);
            }
            if (scan_here) {
#pragma unroll
                for (int c = 0; c < 2; ++c) {
                    uint2 w; w.x = pk2(S[0], S[1]); w.y = pk2(S[2], S[3]);
                    *(uint2*)(stp + (size_t)(2 * tt + c) * 16384) = w;
                    S = cd[c] * S + __builtin_convertvector(csl[c], f32x4);
                    csl[c] = nsl[c]; cd[c] = nd[c];
                }
            }
            wave_lds_sync();
            f32x4 y = {0.f, 0.f, 0.f, 0.f};
            y = MFMA16(a, dfr, y);
#pragma unroll
            for (int ks = 0; ks < 4; ++ks) { const bf16x8 af = *(const bf16x8*)(Hw + fr * 272 + (ks * 32 + fq * 8) * 2); y = MFMA16(af, cfr[ks], y); }
            if (tt < 15) S5_BU(a1);
#pragma unroll
            for (int j = 0; j < 4; ++j) {
                const size_t tok = (size_t)(tokb + 4 * fq + j);
                G[tok * 512 + g * 16 + fr] = f2bf(geluf_(y[j]));
            }
            wave_lds_sync();
            a = a1; a1 = a2;
        }
#undef S5_BU
        if (run == 7) { P.out[O_PRE + (size_t)b * 2048 + g * 64 + p] = hr; P.out[O_PIM + (size_t)b * 2048 + g * 64 + p] = hi; }
        if (scan_here) {
#pragma unroll
            for (int j = 0; j < 4; ++j) P.out[O_PHG + ((size_t)sbh * 128 + 4 * sk4 + j) * 128 + sv] = S[j];
        }
    }
}

DI void phase_final_norm(const Params& P) {
    const float* ssq = (const float*)(P.ws + OFF_SSQ); const float* gf = P.in[20];
    const int gt = blockIdx.x * NTHR + tidx(), ngt = gridDim.x * NTHR;
    for (int i = gt; i < (NTOK - NP) * 256; i += ngt) {
        const int r = NP + (i >> 8), c4 = (i & 255) * 4;
        const float rstd = rsqrtf(ssq[r] * (1.0f / 1024.0f) + EPSF);
        f32x4 v = *(f32x4*)(P.out + (size_t)r * 1024 + c4);
        const f32x4 g4 = *(const f32x4*)(gf + c4);
        v = v * rstd * g4;
        *(f32x4*)(P.out + (size_t)r * 1024 + c4) = v;
    }
}

__global__ __launch_bounds__(512, 2) void fwd_megakernel(Params P) {
    extern __shared__ __attribute__((aligned(16))) unsigned char shm[];
    cg::grid_group grid = cg::this_grid();
    unsigned char* ws = P.ws;
    if (ws == nullptr) grid.sync();
    if (threadIdx.x == 0) *(uint4*)(shm + 131072) = make_uint4(0u, 0u, 0u, 0u);
    __syncthreads();
    const XcdBarrier xb = xcd_barrier_post((unsigned*)(ws + OFF_BAR), (volatile LAS unsigned*)(shm + 131072));
    pg8::StaticOrder S;
    phase_prep(P, shm);
    xcd_barrier(xb);
    { pg8::Gemm g; g.A = (const pg8::bf16_t*)(ws + OFF_HB); g.Bt = (const pg8::bf16_t*)(ws + OFF_WIN); g.M = NP; g.N = 3072; g.K = 1024;
      S.init(g.M, g.N, (int)gridDim.x, (int)blockIdx.x); EpiProj E; E.ws = ws;
      pg8::gemm_phase<EpiProj, pg8::StaticOrder, false>((PG8_LAS unsigned char*)shm, g, S, E, nullptr);
      for (int t = blockIdx.x; t < 384; t += gridDim.x) {
          const int rt = t / 48, ct = t - rt * 48;
          small_gemm_tile<4>((const u16*)(ws + OFF_HB), 1024, (const u16*)(ws + OFF_WIN), 1024, NP + rt * 64, ct * 64, shm, [&](int row, int col, f32x4 v) { proj_store4(ws, row, col, v); });
      } }
    xcd_barrier(xb);
    { HCols cur, nxt; hgrn_load_cols<false>(P, blockIdx.x, cur);
      s5_pass1(P);
      for (int unit = blockIdx.x; unit < 1024; unit += gridDim.x) {
          const int nu = unit + (int)gridDim.x;
          hgrn_unit<false>(P, shm, unit, cur, nu < 1024 ? nu : unit, nxt); cur = nxt; } }
    if (blockIdx.x < 512) {
        f32x4 s0a[8], s0b[8]; hgrn_sample_load(P, blockIdx.x, s0a);
        for (int task = blockIdx.x; task < 512; task += gridDim.x) {
            const int nt = task + (int)gridDim.x;
            hgrn_sample(P, shm, task, s0a, nt < 512 ? nt : task, s0b);
#pragma unroll
            for (int i = 0; i < 8; ++i) s0a[i] = s0b[i];
        }
    }
    s5_sample(P, shm);
    xcd_barrier(xb);
    if (gridDim.x == 256) s5_pass2<true>(P, shm);
    else { phase_scan(P); s5_pass2<false>(P, shm); }
    xcd_barrier(xb);
    { pg8::Gemm g; g.A = (const pg8::bf16_t*)(ws + OFF_G); g.Bt = (const pg8::bf16_t*)(ws + OFF_WGLU); g.M = NP; g.N = 512; g.K = 512;
      S.init(g.M, g.N, (int)gridDim.x, (int)blockIdx.x); EpiGlu E; E.ws = ws; E.bglu = P.in[16];
      pg8::gemm_phase<EpiGlu, pg8::StaticOrder, false>((PG8_LAS unsigned char*)shm, g, S, E, nullptr);
      __syncthreads();
      if (gridDim.x == 256) {
          const int c = (int)blockIdx.x;
          const int u0 = c < 128 ? c * 2 : 256 + (c - 128) * 6, nu = c < 128 ? 2 : 6;
          HCols cur, nxt; hgrn_load_cols<true>(P, u0, cur);
          for (int i = 0; i < nu; ++i) { hgrn_unit<true>(P, shm, u0 + i, cur, i + 1 < nu ? u0 + i + 1 : u0 + i, nxt); cur = nxt; }
      } else {
          HCols cur, nxt; if (blockIdx.x < 1024) hgrn_load_cols<true>(P, blockIdx.x, cur);
          for (int unit = blockIdx.x; unit < 1024; unit += gridDim.x) { const int nu2 = unit + (int)gridDim.x; hgrn_unit<true>(P, shm, unit, cur, nu2 < 1024 ? nu2 : unit, nxt); cur = nxt; } }
      const int nbusy = 128 < (int)gridDim.x ? 128 : 0;
      for (int t = (int)blockIdx.x - nbusy; t >= 0 && t < 64; t += (int)gridDim.x - nbusy) {
          const float* bglu = P.in[16];
          small_gemm_tile<2>((const u16*)(ws + OFF_G), 512, (const u16*)(ws + OFF_WGLU), 512, NP + (t >> 3) * 64, (t & 7) * 64, shm, [&](int row, int col, f32x4 v) {
              const size_t o = (size_t)row * 512 + col;
              const f32x4 b4 = *(const f32x4*)(bglu + col);
              const uint2 g2 = *(const uint2*)((const u16*)(ws + OFF_G) + o), z2 = *(const uint2*)((const u16*)(ws + OFF_SZS) + o);
              const float o0 = __uint_as_float(g2.x << 16) * sigmoidf_(v[0] + b4[0]) * __uint_as_float(z2.x << 16);
              const float o1 = __uint_as_float(g2.x & 0xffff0000u) * sigmoidf_(v[1] + b4[1]) * __uint_as_float(z2.x & 0xffff0000u);
              const float o2 = __uint_as_float(g2.y << 16) * sigmoidf_(v[2] + b4[2]) * __uint_as_float(z2.y << 16);
              const float o3 = __uint_as_float(g2.y & 0xffff0000u) * sigmoidf_(v[3] + b4[3]) * __uint_as_float(z2.y & 0xffff0000u);
              uint2 w; w.x = pk2(o0, o1); w.y = pk2(o2, o3);
              *(uint2*)((u16*)(ws + OFF_CAT) + (size_t)row * 1024 + col) = w; });
      } }
    xcd_barrier(xb);
    { pg8::Gemm g; g.A = (const pg8::bf16_t*)(ws + OFF_CAT); g.Bt = (const pg8::bf16_t*)(ws + OFF_WOUT); g.M = NP; g.N = 1024; g.K = 1024;
      PanelOrder PO; PO.c = (int)blockIdx.x;
      EpiOutNorm E; E.xp = P.in[0]; E.out = P.out; E.gfin = P.in[20]; E.xs = (float*)(ws + OFF_XS); E.cnt = (unsigned*)(ws + OFF_CNT);
      pg8::gemm_phase<EpiOutNorm, PanelOrder, false>((PG8_LAS unsigned char*)shm, g, PO, E, nullptr);
      float* ssq = (float*)(ws + OFF_SSQ); const float* xs = P.in[1]; float* out = P.out;
      for (int t = blockIdx.x; t < 128; t += gridDim.x) {
          small_gemm_tile<4>((const u16*)(ws + OFF_CAT), 1024, (const u16*)(ws + OFF_WOUT), 1024, NP + (t >> 4) * 64, (t & 15) * 64, shm, [&](int row, int col, f32x4 v) {
              const f32x4 r = v + *(const f32x4*)(xs + (size_t)(row - NP) * 1024 + col);
              *(f32x4*)(out + (size_t)row * 1024 + col) = r;
              float ss = r[0] * r[0] + r[1] * r[1] + r[2] * r[2] + r[3] * r[3];
              ss += __shfl_xor(ss, 1); ss += __shfl_xor(ss, 2); ss += __shfl_xor(ss, 4);
              if ((threadIdx.x & 7) == 0) atomicAdd(ssq + row, ss); });
      } }
    xcd_barrier(xb);
    phase_final_norm(P);
}

extern "C" void kernel_launch(void* const* d_in, const int* in_sizes, int n_in, void* d_out, int out_size, void* d_ws, size_t ws_size, hipStream_t stream) {
    static int grid_blocks = 0;
    if (!grid_blocks) {
        int dev = 0, cus = 0, per_cu = 0;
        hipGetDevice(&dev);
        hipDeviceGetAttribute(&cus, hipDeviceAttributeMultiprocessorCount, dev);
        hipFuncSetAttribute((const void*)fwd_megakernel, hipFuncAttributeMaxDynamicSharedMemorySize, LDS_BYTES);
        hipOccupancyMaxActiveBlocksPerMultiprocessor(&per_cu, (const void*)fwd_megakernel, NTHR, LDS_BYTES);
        if (per_cu < 1) per_cu = 1;
        if (per_cu > 1) per_cu = 1;
        grid_blocks = cus * per_cu;
        if (grid_blocks != 256) fprintf(stderr, "kernel_launch: built for a 256-CU device (one workgroup per CU); got %d\n", grid_blocks);
        if (ws_size < WS_END) fprintf(stderr, "kernel_launch: workspace too small: %zu < %zu\n", ws_size, (size_t)WS_END);
    }
    if (hipMemsetAsync((unsigned char*)d_ws + OFF_BAR, 0, ZERO_BYTES, stream) != hipSuccess) fprintf(stderr, "kernel_launch: memset of barrier words failed\n");
    Params p{};
    for (int i = 0; i < 21; ++i) p.in[i] = (const float*)d_in[i];
    p.out = (float*)d_out; p.ws = (unsigned char*)d_ws;
    void* args[] = {&p};
    hipError_t e = hipLaunchCooperativeKernel((void*)fwd_megakernel, dim3(grid_blocks), dim3(NTHR), args, LDS_BYTES, stream);
    if (e != hipSuccess) fprintf(stderr, "cooperative launch failed: %s (grid %d)\n", hipGetErrorString(e), grid_blocks);
}
```

```cpp
#include <hip/hip_runtime.h>
#include <hip/hip_cooperative_groups.h>
#include <cstdio>
namespace cg = cooperative_groups;
namespace pg8 {
#define PG8_LAS __attribute__((address_space(3)))
typedef unsigned short bf16_t;
typedef short bf16x8 __attribute__((ext_vector_type(8)));
typedef float f32x4 __attribute__((ext_vector_type(4)));
typedef unsigned u32x4 __attribute__((ext_vector_type(4)));
constexpr int BM = 256, BK = 64, HALF = 128, HTB = HALF * BK * 2  , STAGE_BYTES = 8 * HTB, NXCD = 8, WGM = 8;

__host__ __device__ __forceinline__ int lds_byte(int r, int c) { const int st = (r >> 4) * 2 + (c >> 5), rr = r & 15, cc = c & 31, ob = rr * 64 + cc * 2; return st * 1024 + (ob ^ (((ob >> 9) & 1) << 5)); }
__host__ __device__ __forceinline__ void stage_rc(int b, int& R, int& C) { const int st = b / 1024, sb = b % 1024, swz = sb ^ (((sb >> 9) & 1) << 5); R = (st >> 1) * 16 + swz / 64; C = (st & 1) * 32 + (swz % 64) / 2; }
__host__ __device__ __forceinline__ int perm32(int rho) { const int n = rho >> 4, i = rho & 15; return 8 * (i >> 2) + 4 * n + (i & 3); }

struct Unit { int pm, pn; };
struct Gemm { const bf16_t* A; const bf16_t* Bt; int M, N, K; };

struct StaticOrder {
    int nM, nN, nwg, G, c;
    __host__ __device__ void init(int M, int N, int G_, int c_) { nM = M / BM; nN = N / BM; nwg = nM * nN; G = G_; c = c_; }
    __host__ __device__ bool next(int i, Unit& u) const {
        const long L = (long)i * G + c; if (L >= nwg) return false;
        int wgid = (int)L; { const int q = nwg / NXCD, r = nwg % NXCD, xcd = wgid % NXCD, off = wgid / NXCD; wgid = (xcd < r ? xcd * (q + 1) : r * (q + 1) + (xcd - r) * q) + off; }
        const int nig = WGM * nN, gid = wgid / nig, fm = gid * WGM, gsz = (nM - fm) < WGM ? (nM - fm) : WGM;
        u.pm = fm + ((wgid % nig) % gsz); u.pn = (wgid % nig) / gsz; return true;
    }
    __device__ __forceinline__ void a_ready(const Unit&) const {}
    __device__ __forceinline__ void done(const Unit&) const {}
};
__device__ __forceinline__ unsigned cvt_pk_bf16(float lo, float hi) { unsigned r; asm volatile("v_cvt_pk_bf16_f32 %0, %1, %2" : "=v"(r) : "v"(lo), "v"(hi)); return r; }
template <class Epi, class Sched, bool STAMP = false>
__device__ __forceinline__ void gemm_phase(PG8_LAS unsigned char* lds, const Gemm g, const Sched& S, const Epi& E, unsigned long long* stamps) {
    const int tid = threadIdx.x, wid = __builtin_amdgcn_readfirstlane(tid >> 6), lane = tid & 63, wr = wid >> 2, wc = wid & 3, fr = lane & 15, fq = lane >> 4;
    const int K = g.K, nt = K / BK;
    int ts_lo = 0, ts_hi = 0, nts = 0; const unsigned long long rt_entry = STAMP ? (unsigned long long)wall_clock64() : 0ull;
#define PG8_STAMP() do { if (STAMP && wid == 0 && nts < 64) { const unsigned long long _c = (unsigned long long)clock64(); \
        ts_lo = (lane == nts) ? (int)(unsigned)_c : ts_lo; ts_hi = (lane == nts) ? (int)(unsigned)(_c >> 32) : ts_hi; ++nts; } } while (0)
    PG8_STAMP();
    unsigned voffA[2], voffB[2];
#pragma unroll
    for (int i = 0; i < 2; ++i) { int R, C; stage_rc(tid * 16 + i * 8192, R, C); const int Rb = Epi::PERM ? ((R & ~31) + perm32(R & 31)) : R;
        voffA[i] = (unsigned)(R * K + C) * 2u; voffB[i] = (unsigned)(Rb * K + C) * 2u; }
    const size_t kstep = (size_t)(BK * 2);
    const size_t hstep = (size_t)HALF * K * 2;
    const size_t tstep = 2 * hstep;
    const unsigned ldsw = (unsigned)wid * 1024u;
    const int aoff = lds_byte(wr * 64 + fr, fq * 8), boff = lds_byte(wc * 32 + fr, fq * 8);
#define PG8_SA(b, h) (((b) * 2 + (h)) * HTB)
#define PG8_SB(b, h) ((4 + (b) * 2 + (h)) * HTB)
#define PG8_STAGE(bufoff, gbase, voff) do { _Pragma("unroll") for (int _i = 0; _i < 2; ++_i) \
        __builtin_amdgcn_global_load_lds((const unsigned*)((const char*)(gbase) + (voff)[_i]), (PG8_LAS unsigned*)(lds + (bufoff) + ldsw + _i * 8192), 16, 0, 0); } while (0)
#define PG8_LDA(dst, b, h) do { _Pragma("unroll") for (int m = 0; m < 4; ++m) _Pragma("unroll") for (int k = 0; k < 2; ++k) dst[m][k] = *(const PG8_LAS bf16x8*)(lds + PG8_SA(b, h) + aoff + m * 2048 + k * 1024); } while (0)
#define PG8_LDB(dst, b, h) do { _Pragma("unroll") for (int n = 0; n < 2; ++n) _Pragma("unroll") for (int k = 0; k < 2; ++k) dst[n][k] = *(const PG8_LAS bf16x8*)(lds + PG8_SB(b, h) + boff + n * 2048 + k * 1024); } while (0)
#define PG8_MMA(ai, bj, At, Bt) do { __builtin_amdgcn_s_setprio(1); _Pragma("unroll") for (int m = 0; m < 4; ++m) _Pragma("unroll") for (int n = 0; n < 2; ++n) _Pragma("unroll") for (int k = 0; k < 2; ++k) \
        acc[ai][bj][m][n] = __builtin_amdgcn_mfma_f32_16x16x32_bf16(Bt[n][k], At[m][k], acc[ai][bj][m][n], 0, 0, 0); __builtin_amdgcn_s_setprio(0); } while (0)
#define PG8_WAIT_V(n) asm volatile("s_waitcnt vmcnt(" #n ")" ::: "memory")
#define PG8_WAIT_L(n) asm volatile("s_waitcnt lgkmcnt(" #n ")" ::: "memory")
#define PG8_BAR __builtin_amdgcn_s_barrier()
#define PG8_SCHED __builtin_amdgcn_sched_barrier(0)
    Unit cur, nxt; int ui = 0;
    if (!S.next(0, cur)) return;
    f32x4 acc[2][2][4][2];
#pragma unroll
    for (int a = 0; a < 2; ++a)
#pragma unroll
        for (int b = 0; b < 2; ++b)
#pragma unroll
            for (int m = 0; m < 4; ++m)
#pragma unroll
                for (int n = 0; n < 2; ++n) acc[a][b][m][n] = (f32x4){0.f, 0.f, 0.f, 0.f};
    bf16x8 At[4][2], B0[2][2], B1[2][2];
    const char* cA = (const char*)g.A + (size_t)cur.pm * tstep; const char* cB = (const char*)g.Bt + (size_t)cur.pn * tstep;
    S.a_ready(cur);
    PG8_STAGE(PG8_SB(0, 0), cB, voffB); PG8_STAGE(PG8_SA(0, 0), cA, voffA); PG8_STAGE(PG8_SB(0, 1), cB + hstep, voffB); PG8_STAGE(PG8_SA(0, 1), cA + hstep, voffA);
    if (wr == 1) PG8_BAR;
    PG8_WAIT_V(4); PG8_BAR;
    PG8_STAGE(PG8_SB(1, 0), cB + kstep, voffB); PG8_STAGE(PG8_SA(1, 0), cA + kstep, voffA); PG8_STAGE(PG8_SB(1, 1), cB + hstep + kstep, voffB);
    PG8_WAIT_V(6); PG8_BAR;
    PG8_STAMP();
    for (;;) {
        const bool has_next = S.next(ui + 1, nxt);
        const char* nA = has_next ? (const char*)g.A + (size_t)nxt.pm * tstep : cA; const char* nB = has_next ? (const char*)g.Bt + (size_t)nxt.pn * tstep : cB;
        for (int t = 0; t < nt; t += 2) {
            const bool last = (t == nt - 2);
            const char* a1 = cA + (size_t)(t + 1) * kstep;
            const char* a2 = last ? nA : cA + (size_t)(t + 2) * kstep; const char* b2 = last ? nB : cB + (size_t)(t + 2) * kstep;
            const char* a3 = a2 + kstep; const char* b3 = b2 + kstep;
            if (last && has_next) S.a_ready(nxt);
            PG8_LDB(B0, 0, 0); PG8_SCHED; PG8_LDA(At, 0, 0); PG8_STAGE(PG8_SA(1, 1), a1 + hstep, voffA);
            PG8_WAIT_L(8); PG8_BAR; PG8_WAIT_L(0); PG8_MMA(0, 0, At, B0); PG8_BAR; PG8_SCHED;
            PG8_LDB(B1, 0, 1); PG8_STAGE(PG8_SB(0, 0), b2, voffB);
            PG8_BAR; PG8_WAIT_L(0); PG8_MMA(0, 1, At, B1); PG8_BAR;
            PG8_LDA(At, 0, 1); PG8_STAGE(PG8_SA(0, 0), a2, voffA);
            PG8_BAR; PG8_WAIT_L(0); PG8_MMA(1, 0, At, B0); PG8_BAR; PG8_SCHED;
            PG8_STAGE(PG8_SB(0, 1), b2 + hstep, voffB);
            PG8_WAIT_V(6); PG8_BAR; PG8_MMA(1, 1, At, B1); PG8_BAR;
            PG8_LDB(B0, 1, 0); PG8_SCHED; PG8_LDA(At, 1, 0); PG8_STAGE(PG8_SA(0, 1), a2 + hstep, voffA);
            PG8_WAIT_L(8); PG8_BAR; PG8_WAIT_L(0); PG8_MMA(0, 0, At, B0); PG8_BAR; PG8_SCHED;
            PG8_LDB(B1, 1, 1); PG8_STAGE(PG8_SB(1, 0), b3, voffB);
            PG8_BAR; PG8_WAIT_L(0); PG8_MMA(0, 1, At, B1); PG8_BAR;
            PG8_LDA(At, 1, 1); PG8_STAGE(PG8_SA(1, 0), a3, voffA);
            PG8_BAR; PG8_WAIT_L(0); PG8_MMA(1, 0, At, B0); PG8_BAR; PG8_SCHED;
            PG8_STAGE(PG8_SB(1, 1), b3 + hstep, voffB);
            PG8_WAIT_V(6); PG8_BAR; PG8_MMA(1, 1, At, B1); PG8_BAR;
        }
        PG8_STAMP();
        if constexpr (!Epi::AFTER_DRAIN) { E(acc, cur, wr, wc, fr, fq); S.done(cur); }
        PG8_STAMP();
        if (!has_next) break;
#pragma unroll
        for (int a = 0; a < 2; ++a)
#pragma unroll
            for (int b = 0; b < 2; ++b)
#pragma unroll
                for (int m = 0; m < 4; ++m)
#pragma unroll
                    for (int n = 0; n < 2; ++n) acc[a][b][m][n] = (f32x4){0.f, 0.f, 0.f, 0.f};
        cur = nxt; cA = nA; cB = nB; ++ui;
    }
    PG8_WAIT_V(0);
    if (wr == 0) PG8_BAR;
    PG8_BAR;
    if constexpr (Epi::AFTER_DRAIN) { E.fused(acc, cur, wr, wc, fr, fq, lds, wid, lane); S.done(cur); }
    PG8_STAMP();
    if (STAMP && wid == 0) { stamps[lane] = lane < nts ? (((unsigned long long)(unsigned)ts_hi << 32) | (unsigned)ts_lo) : 0ull;
        if (lane == 62) stamps[62] = rt_entry; if (lane == 63) stamps[63] = (unsigned long long)wall_clock64(); }
#undef PG8_STAMP
#undef PG8_SA
#undef PG8_SB
#undef PG8_STAGE
#undef PG8_LDA
#undef PG8_LDB
#undef PG8_MMA
#undef PG8_WAIT_V
#undef PG8_WAIT_L
#undef PG8_BAR
#undef PG8_SCHED
}
}

#define XB_TMO      128
#define XB_XCNT(j)  (256  + 64 * (j))
#define XB_XSUB(j)  (1280 + 64 * (j))
#define XB_XGEN(j)  (2304 + 64 * (j))
#define XB_TOP      3328
#define XB_TOPGEN   3392
#define XCD_BAR_WORDS 3456
#define XB_SPIN_CAP (1u << 18)
#define LAS __attribute__((address_space(3)))

__device__ __forceinline__ unsigned xb_ld(unsigned* p)              { return __hip_atomic_load(p, __ATOMIC_RELAXED, __HIP_MEMORY_SCOPE_AGENT); }
__device__ __forceinline__ unsigned xb_add(unsigned* p, unsigned v) { return __hip_atomic_fetch_add(p, v, __ATOMIC_RELAXED, __HIP_MEMORY_SCOPE_AGENT); }
__device__ __forceinline__ unsigned xb_xcc_id() { return (unsigned)__builtin_amdgcn_s_getreg((3 << 11) | 20) & 0xFu; }
#define XB_SPIN(cond, bar) do { unsigned _sp = 0; while (cond) { __builtin_amdgcn_s_sleep(1); \
    if ((++_sp & 255u) == 0u) { if (xb_ld(&(bar)[XB_TMO])) break; if (_sp > XB_SPIN_CAP) { atomicAdd(&(bar)[XB_TMO], 1u); break; } } } } while (0)

struct XcdBarrier {
    unsigned* bar; unsigned x;
    volatile LAS unsigned* st;
};

__device__ __forceinline__ XcdBarrier xcd_barrier_post(unsigned* bar, volatile LAS unsigned* st) {
    XcdBarrier b; b.bar = bar; b.x = xb_xcc_id(); b.st = st;
    if (threadIdx.x == 0) (void)xb_add(&bar[XB_XCNT(b.x)], 1u);
    return b;
}
__device__ __forceinline__ void xcd_barrier_complete(unsigned* bar, unsigned x, unsigned& nloc, unsigned& nx) {
    const unsigned G = gridDim.x * gridDim.y * gridDim.z;
    unsigned sum, cnt, mine, sp = 0u;
    for (;;) {
        sum = 0u; cnt = 0u; mine = 0u;
#pragma unroll
        for (unsigned j = 0; j < 16; ++j) { const unsigned c = xb_ld(&bar[XB_XCNT(j)]); sum += c; cnt += (c > 0u) ? 1u : 0u; mine = (j == x) ? c : mine; }
        if (sum == G) break;
        __builtin_amdgcn_s_sleep(1);
        if ((++sp & 255u) == 0u) { if (xb_ld(&bar[XB_TMO])) break; if (sp > XB_SPIN_CAP) { atomicAdd(&bar[XB_TMO], 1u); break; } }
    }
    nloc = mine > 0u ? mine : 1u; nx = cnt > 0u ? cnt : 1u;
}

__device__ __forceinline__ void xcd_barrier(const XcdBarrier& b) {
    asm volatile("s_waitcnt vmcnt(0)" ::: "memory");
    __syncthreads();
    if (threadIdx.x == 0) {
        unsigned* bar = b.bar;
        __builtin_amdgcn_s_waitcnt(0);
        unsigned nloc = b.st[0], nx = b.st[1];
        if (nloc == 0u) { xcd_barrier_complete(bar, b.x, nloc, nx); b.st[0] = nloc; b.st[1] = nx; }
        const unsigned old = xb_add(&bar[XB_XSUB(b.x)], 1u);
        const unsigned gen = old / nloc;
        if (old + 1u == (gen + 1u) * nloc) {
            __builtin_amdgcn_fence(__ATOMIC_RELEASE, "agent");
            asm volatile("s_waitcnt vmcnt(0)" ::: "memory");
            const unsigned og = xb_add(&bar[XB_TOP], 1u);
            const unsigned tg = og / nx;
            if (og + 1u == (tg + 1u) * nx) xb_add(&bar[XB_TOPGEN], 1u);
            else XB_SPIN(xb_ld(&bar[XB_TOPGEN]) == tg, bar);
            __builtin_amdgcn_fence(__ATOMIC_ACQUIRE, "agent");
            xb_add(&bar[XB_XGEN(b.x)], 1u);
            asm volatile("s_waitcnt vmcnt(0)" ::: "memory");
        } else {
            XB_SPIN(xb_ld(&bar[XB_XGEN(b.x)]) == gen, bar);
            __builtin_amdgcn_fence(__ATOMIC_ACQUIRE, "agent");
            asm volatile("s_waitcnt vmcnt(0)" ::: "memory");
        }
    }
    __syncthreads();
}


typedef unsigned short u16;
using pg8::bf16x8; using pg8::f32x4; using pg8::u32x4;
typedef float f32x16 __attribute__((ext_vector_type(16)));
typedef short s16x4 __attribute__((ext_vector_type(4)));
typedef _Float16 h16x4 __attribute__((ext_vector_type(4)));
#define DI __device__ __forceinline__
DI int tidx() { int t = (int)threadIdx.x; asm volatile("" : "+v"(t)); return t; }
#define MFMA16(a, b, c) __builtin_amdgcn_mfma_f32_16x16x32_bf16((a), (b), (c), 0, 0, 0)
#define MFMA32(a, b, c) __builtin_amdgcn_mfma_f32_32x32x16_bf16((a), (b), (c), 0, 0, 0)

constexpr int NP = 16384, NTOK = 16896, NTHR = 512;
constexpr float EPSF = 1e-6f;
constexpr size_t SZT = (size_t)NTOK * 512 * 2;
constexpr size_t OFF_HB = 0;
constexpr size_t OFF_WIN = OFF_HB + (size_t)NTOK * 1024 * 2;
constexpr size_t OFF_WGLU = OFF_WIN + (size_t)3072 * 1024 * 2;
constexpr size_t OFF_WOUT = OFF_WGLU + (size_t)512 * 512 * 2;
constexpr size_t OFF_U = OFF_WOUT + (size_t)1024 * 1024 * 2;
constexpr size_t OFF_SZS = OFF_U + SZT;
constexpr size_t OFF_Q = OFF_SZS + SZT;
constexpr size_t OFF_KK = OFF_Q + SZT;
constexpr size_t OFF_V = OFF_KK + SZT;
constexpr size_t OFF_SZH = OFF_V + SZT;
constexpr size_t OFF_LF = OFF_SZH + SZT;
constexpr size_t OFF_G = OFF_LF + (size_t)NTOK * 512 * 4;
constexpr size_t OFF_CAT = OFF_G + SZT;
constexpr size_t OFF_DEC = OFF_CAT + (size_t)NTOK * 1024 * 2;
constexpr size_t OFF_HEND = OFF_DEC + (size_t)1024 * 128 * 4;
constexpr size_t OFF_HCAR = OFF_HEND + (size_t)256 * 2048 * 8;
constexpr size_t OFF_APOW = OFF_HCAR + (size_t)256 * 2048 * 8;
constexpr size_t OFF_BBR = OFF_APOW + (size_t)2048 * 65 * 8;
constexpr size_t OFF_BBI = OFF_BBR + (size_t)2048 * 16 * 2;
constexpr size_t OFF_CMT = OFF_BBI + (size_t)2048 * 16 * 2;
constexpr size_t OFF_LB = OFF_CMT + (size_t)32 * 16 * 128 * 2;
constexpr size_t OFF_SSQ = OFF_LB + 2048;
constexpr size_t OFF_BAR = OFF_SSQ + (size_t)NTOK * 4;
constexpr size_t OFF_CNT = OFF_BAR + (size_t)XCD_BAR_WORDS * 4;
constexpr size_t ZERO_BYTES = (size_t)XCD_BAR_WORDS * 4 + 64 * 256;
constexpr size_t OFF_XS = OFF_CNT + 64 * 256;
constexpr size_t WS_END = OFF_XS + (size_t)64 * 256 * 4 * 4;
constexpr size_t O_Y = 0, O_PRE = 17301504, O_PIM = 17317888, O_PHG = 17334272, O_SRE = 17858560, O_SIM = 18120704, O_SHG = 18382848;
constexpr int LDS_BYTES = 131072 + 16;

struct Params { const float* in[21]; float* out; unsigned char* ws; };

DI u16 f2bf(float f) { unsigned r; asm volatile("v_cvt_pk_bf16_f32 %0, %1, %1" : "=v"(r) : "v"(f)); return (u16)(r & 0xffffu); }
DI float bf2f(u16 h) { return __uint_as_float((unsigned)h << 16); }
DI unsigned pk2(float lo, float hi) { unsigned r; asm volatile("v_cvt_pk_bf16_f32 %0, %1, %2" : "=v"(r) : "v"(lo), "v"(hi)); return r; }
DI float wave_sum(float v) {
#pragma unroll
    for (int o = 32; o > 0; o >>= 1) v += __shfl_xor(v, o);
    return v;
}
DI float sigmoidf_(float x) { return 1.0f / (1.0f + __expf(-x)); }
DI float siluf_(float x) { return x / (1.0f + __expf(-x)); }
DI float geluf_(float x) { const float u = 0.7978845608f * (x + 0.044715f * x * x * x); return x / (1.0f + __expf(-2.0f * u)); }
DI void wave_lds_sync() { __builtin_amdgcn_fence(__ATOMIC_RELEASE, "wavefront"); asm volatile("s_waitcnt lgkmcnt(0)" ::: "memory"); __builtin_amdgcn_wave_barrier(); __builtin_amdgcn_fence(__ATOMIC_ACQUIRE, "wavefront"); }

struct TDesc { const float* src; u16* dst; };
DI TDesc transpose_desc(const Params& P, int item, int t) {
    const float* W; u16* Wt; int K, N, tk, tn;
    if (item < 768) { W = P.in[6]; Wt = (u16*)(P.ws + OFF_WIN); K = 1024; N = 3072; tk = item & 15; tn = item >> 4; }
    else if (item < 832) { const int i2 = item - 768; W = P.in[15]; Wt = (u16*)(P.ws + OFF_WGLU); K = 512; N = 512; tk = i2 & 7; tn = i2 >> 3; }
    else { const int i2 = item - 832; W = P.in[19]; Wt = (u16*)(P.ws + OFF_WOUT); K = 1024; N = 1024; tk = i2 & 15; tn = i2 >> 4; }
    TDesc d; d.src = W + (size_t)(tk * 64 + (t >> 3)) * N + tn * 64 + (t & 7) * 8; d.dst = Wt + (size_t)(tn * 64 + (t >> 3)) * K + tk * 64 + (t & 7) * 8; return d;
}

DI void phase_prep(const Params& P, unsigned char* lds) {
    unsigned char* ws = P.ws;
    const int tid = tidx(), lane = tid & 63, wid = tid >> 6;
    { u16* HB = (u16*)(ws + OFF_HB); const float* ng = P.in[5];
      const int gw = blockIdx.x * 8 + wid, nw = gridDim.x * 8;
      f32x4 g4[4], v[4];
#pragma unroll
      for (int i = 0; i < 4; ++i) g4[i] = *(const f32x4*)(ng + i * 256 + lane * 4);
      const int nrow = (nw == 2048) ? (gw >= 1536 ? 9 : 8) : (NTOK - gw + nw - 1) / nw;
      auto rowk = [&](int k) { return (nw == 2048 && k == 8) ? NP + (gw - 1536) : gw + k * nw; };
      if (nrow > 0) { const int r0 = rowk(0); const float* xr = (r0 < NP) ? P.in[0] + (size_t)r0 * 1024 : P.in[1] + (size_t)(r0 - NP) * 1024;
#pragma unroll
          for (int i = 0; i < 4; ++i) v[i] = __builtin_nontemporal_load((const f32x4*)(xr + i * 256 + lane * 4)); }
      for (int k = 0; k < nrow; ++k) {
          const int r = rowk(k), rn = rowk(k + 1 < nrow ? k + 1 : k);
          const float* xn = (rn < NP) ? P.in[0] + (size_t)rn * 1024 : P.in[1] + (size_t)(rn - NP) * 1024;
          f32x4 vn[4];
#pragma unroll
          for (int i = 0; i < 4; ++i) vn[i] = __builtin_nontemporal_load((const f32x4*)(xn + i * 256 + lane * 4));
          float ss = 0.f;
#pragma unroll
          for (int i = 0; i < 4; ++i) ss += v[i][0] * v[i][0] + v[i][1] * v[i][1] + v[i][2] * v[i][2] + v[i][3] * v[i][3];
          ss = wave_sum(ss);
          const float rstd = rsqrtf(ss * (1.0f / 1024.0f) + EPSF);
#pragma unroll
          for (int i = 0; i < 4; ++i) {
              const f32x4 o = v[i] * rstd * g4[i];
              uint2 w; w.x = pk2(o[0], o[1]); w.y = pk2(o[2], o[3]);
              *(uint2*)(HB + (size_t)r * 1024 + i * 256 + lane * 4) = w; v[i] = vn[i]; }
      } }
    { float* tile = (float*)lds;
      int item = blockIdx.x;
      if (item < 1088) {
          TDesc cur = transpose_desc(P, item, tid);
          float4 a = *(const float4*)cur.src, b = *(const float4*)(cur.src + 4);
          for (; item < 1088; item += gridDim.x) {
              const int ni = (item + (int)gridDim.x < 1088) ? item + (int)gridDim.x : item;
              const TDesc nxt = transpose_desc(P, ni, tid);
              const float4 na = *(const float4*)nxt.src, nb = *(const float4*)(nxt.src + 4);
              { float* d = tile + (tid >> 3) * 65 + (tid & 7) * 8; d[0] = a.x; d[1] = a.y; d[2] = a.z; d[3] = a.w; d[4] = b.x; d[5] = b.y; d[6] = b.z; d[7] = b.w; }
              __syncthreads();
              { const int n = tid >> 3, k8 = (tid & 7) * 8; float v[8];
#pragma unroll
                for (int j = 0; j < 8; ++j) v[j] = tile[(k8 + j) * 65 + n];
                u32x4 w; w.x = pk2(v[0], v[1]); w.y = pk2(v[2], v[3]); w.z = pk2(v[4], v[5]); w.w = pk2(v[6], v[7]);
                *(u32x4*)cur.dst = w; }
              __syncthreads();
              a = na; b = nb; cur = nxt;
          }
      } }
    { const int gt = blockIdx.x * NTHR + tid, ngt = gridDim.x * NTHR;
      for (int i = gt; i < 2048 * 65; i += ngt) {
          const int gp = i / 65, j = i - gp * 65, g = gp >> 6;
          const double lr = fmin((double)P.in[7][gp], -1e-4), li = (double)P.in[8][gp], dt = exp((double)P.in[9][g]);
          const double x = li * dt * (double)j; const double n = rint(x * 0.15915494309189535); const double r = x - n * 6.283185307179586;
          const float m = expf((float)(lr * dt * (double)j)), rf = (float)r;
          ((float2*)(ws + OFF_APOW))[i] = make_float2(m * cosf(rf), m * sinf(rf));
      }
      for (int i = (ngt >= 65536 ? gt - 32768 : gt); i >= 0 && i < 2048 * 16; i += ngt) {
          const int gp = i >> 4, c = i & 15, g = gp >> 6, p = gp & 63;
          const double lr = fmin((double)P.in[7][gp], -1e-4), li = (double)P.in[8][gp], dt = exp((double)P.in[9][g]);
          const double x = li * dt; const double n = rint(x * 0.15915494309189535); const double r = x - n * 6.283185307179586;
          const double m = exp(lr * dt); const double are = m * cos(r), aim = m * sin(r);
          const double den = lr * lr + li * li;
          const double zr = ((are - 1.0) * lr + aim * li) / den, zi = (aim * lr - (are - 1.0) * li) / den;
          const double br = (double)P.in[10][i], bi = (double)P.in[11][i];
          ((u16*)(ws + OFF_BBR))[i] = f2bf((float)(zr * br - zi * bi)); ((u16*)(ws + OFF_BBI))[i] = f2bf((float)(zr * bi + zi * br));
          u16* cm = (u16*)(ws + OFF_CMT) + ((size_t)g * 16 + c) * 128;
          cm[2 * p] = f2bf(P.in[12][((size_t)g * 16 + c) * 64 + p]); cm[2 * p + 1] = f2bf(-P.in[13][((size_t)g * 16 + c) * 64 + p]);
      }
      for (int i = gt; i < 512; i += ngt) { const float l0 = P.in[17][i], l1 = P.in[17][512 + i]; ((float*)(ws + OFF_LB))[i] = 1.0f / (1.0f + expf(l1 - l0)); }
      for (int i = gt; i < NTOK; i += ngt) ((float*)(ws + OFF_SSQ))[i] = 0.f;
    }
}

struct EpiProj {
    static constexpr bool PERM = true, AFTER_DRAIN = false;
    unsigned char* ws;
    DI void operator()(const f32x4 (&acc)[2][2][4][2], const pg8::Unit& u, int wr, int wc, int fr, int fq) const {
        const int type = u.pn >> 1;
        const int cbase = (u.pn & 1) * 256 + wc * 32 + 8 * fq;
        const int row0 = u.pm * 256 + wr * 64 + fr;
        if (type == 3) {
            const float* LB = (const float*)(ws + OFF_LB); _Float16* LF = (_Float16*)(ws + OFF_LF);
#pragma unroll
            for (int bj = 0; bj < 2; ++bj) {
                const int col = cbase + bj * 128;
                const f32x4 lb0 = *(const f32x4*)(LB + col), lb1 = *(const f32x4*)(LB + col + 4);
#pragma unroll
                for (int ai = 0; ai < 2; ++ai)
#pragma unroll
                    for (int m = 0; m < 4; ++m) {
                        const size_t row = (size_t)(row0 + ai * 128 + m * 16);
                        f32x4 lf0, lf1;
#pragma unroll
                        for (int j = 0; j < 8; ++j) {
                            float x = (j < 4) ? acc[ai][bj][m][0][j & 3] : acc[ai][bj][m][1][j & 3];
                            const float lb = (j < 4) ? lb0[j & 3] : lb1[j & 3];
                            x = fminf(fmaxf(x, -30.f), 30.f);
                            const float e = __expf(-x), sg = 1.0f / (1.0f + e);
                            const float f = lb + (1.0f - lb) * sg;
                            const float l = __logf(f);
                            if (j < 4) lf0[j & 3] = l; else lf1[j & 3] = l;
                        }
                        *(h16x4*)(LF + row * 512 + col) = __builtin_convertvector(lf0, h16x4); *(h16x4*)(LF + row * 512 + col + 4) = __builtin_convertvector(lf1, h16x4);
                    }
            }
        } else {
            const bool act = (type == 1) || (type == 5);
            u16* O = (u16*)(ws + (type == 0 ? OFF_U : type == 1 ? OFF_SZS : type == 2 ? OFF_Q : type == 4 ? OFF_V : OFF_SZH));
#pragma unroll
            for (int ai = 0; ai < 2; ++ai)
#pragma unroll
                for (int m = 0; m < 4; ++m) {
                    const size_t row = (size_t)(row0 + ai * 128 + m * 16);
#pragma unroll
                    for (int bj = 0; bj < 2; ++bj) {
                        f32x4 v0 = acc[ai][bj][m][0], v1 = acc[ai][bj][m][1];
                        if (act) {
#pragma unroll
                            for (int j = 0; j < 4; ++j) { v0[j] = siluf_(v0[j]); v1[j] = siluf_(v1[j]); }
                        }
                        u32x4 w; w.x = pk2(v0[0], v0[1]); w.y = pk2(v0[2], v0[3]); w.z = pk2(v1[0], v1[1]); w.w = pk2(v1[2], v1[3]);
                        *(u32x4*)(O + row * 512 + cbase + bj * 128) = w;
                    }
                }
        }
    }
};

struct EpiGlu {
    static constexpr bool PERM = true, AFTER_DRAIN = false;
    unsigned char* ws; const float* bglu;
    DI void operator()(const f32x4 (&acc)[2][2][4][2], const pg8::Unit& u, int wr, int wc, int fr, int fq) const {
        const u16* G = (const u16*)(ws + OFF_G); const u16* SZS = (const u16*)(ws + OFF_SZS); u16* CAT = (u16*)(ws + OFF_CAT);
        const int cbase = u.pn * 256 + wc * 32 + 8 * fq;
        const int row0 = u.pm * 256 + wr * 64 + fr;
#pragma unroll
        for (int bj = 0; bj < 2; ++bj) {
            const int col = cbase + bj * 128;
            const f32x4 b0 = *(const f32x4*)(bglu + col), b1 = *(const f32x4*)(bglu + col + 4);
#pragma unroll
            for (int ai = 0; ai < 2; ++ai)
#pragma unroll
                for (int m = 0; m < 4; ++m) {
                    const size_t row = (size_t)(row0 + ai * 128 + m * 16);
                    const u32x4 g8 = *(const u32x4*)(G + row * 512 + col), z8 = *(const u32x4*)(SZS + row * 512 + col);
                    float o[8];
#pragma unroll
                    for (int j = 0; j < 8; ++j) {
                        const float a = ((j < 4) ? acc[ai][bj][m][0][j & 3] : acc[ai][bj][m][1][j & 3]) + ((j < 4) ? b0[j & 3] : b1[j & 3]);
                        const unsigned gw = g8[j >> 1], zw = z8[j >> 1];
                        const float gv = (j & 1) ? __uint_as_float(gw & 0xffff0000u) : __uint_as_float(gw << 16);
                        const float zv = (j & 1) ? __uint_as_float(zw & 0xffff0000u) : __uint_as_float(zw << 16);
                        o[j] = gv * sigmoidf_(a) * zv;
                    }
                    u32x4 w; w.x = pk2(o[0], o[1]); w.y = pk2(o[2], o[3]); w.z = pk2(o[4], o[5]); w.w = pk2(o[6], o[7]);
                    *(u32x4*)(CAT + row * 1024 + col) = w;
                }
        }
    }
};

struct PanelOrder {
    int c;
    __device__ bool next(int i, pg8::Unit& u) const { if (i > 0) return false; u.pm = (c & 7) * 8 + (c >> 5); u.pn = (c >> 3) & 3; return true; }
    DI void a_ready(const pg8::Unit&) const {}
    DI void done(const pg8::Unit&) const {}
};

struct EpiOutNorm {
    static constexpr bool PERM = false, AFTER_DRAIN = true;
    const float* xp; float* out; const float* gfin; float* xs; unsigned* cnt;
    DI void fused(f32x4 (&acc)[2][2][4][2], const pg8::Unit& u, int wr, int wc, int fr, int fq, PG8_LAS unsigned char* lds, int wid, int lane) const {
        PG8_LAS float* Pl = (PG8_LAS float*)lds;
        PG8_LAS float* Sl = (PG8_LAS float*)(lds + 4096);
        const int rl0 = wr * 64 + fr, col0 = u.pn * 256 + wc * 32 + 4 * fq;
#pragma unroll
        for (int ai = 0; ai < 2; ++ai) {
            f32x4 xv[4][2][2];
#pragma unroll
            for (int m = 0; m < 4; ++m)
#pragma unroll
                for (int bj = 0; bj < 2; ++bj)
#pragma unroll
                    for (int n = 0; n < 2; ++n) xv[m][bj][n] = __builtin_nontemporal_load((const f32x4*)(xp + (size_t)(u.pm * 256 + rl0 + ai * 128 + m * 16) * 1024 + col0 + bj * 128 + n * 16));
#pragma unroll
            for (int m = 0; m < 4; ++m) {
                const int rl = rl0 + ai * 128 + m * 16;
                float ss = 0.f;
#pragma unroll
                for (int bj = 0; bj < 2; ++bj)
#pragma unroll
                    for (int n = 0; n < 2; ++n) {
                        const f32x4 r = acc[ai][bj][m][n] + xv[m][bj][n];
                        acc[ai][bj][m][n] = r;
                        ss += r[0] * r[0] + r[1] * r[1] + r[2] * r[2] + r[3] * r[3];
                    }
                ss += __shfl_xor(ss, 16); ss += __shfl_xor(ss, 32);
                if (fq == 0) Pl[rl * 4 + wc] = ss;
            }
        }
        f32x4 g4[2][2];
#pragma unroll
        for (int bj = 0; bj < 2; ++bj)
#pragma unroll
            for (int n = 0; n < 2; ++n) g4[bj][n] = *(const f32x4*)(gfin + col0 + bj * 128 + n * 16);
        __syncthreads();
        const int tid = wid * 64 + lane;
        if (tid < 256) {
            const float t = (Pl[tid * 4 + 0] + Pl[tid * 4 + 1]) + (Pl[tid * 4 + 2] + Pl[tid * 4 + 3]);
            __hip_atomic_store(xs + ((size_t)u.pm * 256 + tid) * 4 + u.pn, t, __ATOMIC_RELAXED, __HIP_MEMORY_SCOPE_AGENT);
        }
        asm volatile("s_waitcnt vmcnt(0)" ::: "memory");
        __syncthreads();
        if (tid == 0) {
            unsigned* c = cnt + (size_t)u.pm * 64;
            __hip_atomic_fetch_add(c, 1u, __ATOMIC_RELAXED, __HIP_MEMORY_SCOPE_AGENT);
            unsigned sp = 0;
            while (__hip_atomic_load(c, __ATOMIC_RELAXED, __HIP_MEMORY_SCOPE_AGENT) < 4u) { __builtin_amdgcn_s_sleep(1); if (++sp > (1u << 22)) break; }
        }
        __syncthreads();
        if (tid < 256) {
            const float* p = xs + ((size_t)u.pm * 256 + tid) * 4;
            const float t = (__hip_atomic_load(p, __ATOMIC_RELAXED, __HIP_MEMORY_SCOPE_AGENT) + __hip_atomic_load(p + 1, __ATOMIC_RELAXED, __HIP_MEMORY_SCOPE_AGENT))
                          + (__hip_atomic_load(p + 2, __ATOMIC_RELAXED, __HIP_MEMORY_SCOPE_AGENT) + __hip_atomic_load(p + 3, __ATOMIC_RELAXED, __HIP_MEMORY_SCOPE_AGENT));
            Sl[tid] = rsqrtf(t * (1.0f / 1024.0f) + EPSF);
        }
        __syncthreads();
#pragma unroll
        for (int ai = 0; ai < 2; ++ai)
#pragma unroll
            for (int m = 0; m < 4; ++m) {
                const int rl = rl0 + ai * 128 + m * 16;
                const float rstd = Sl[rl];
                float* orow = out + (size_t)(u.pm * 256 + rl) * 1024 + col0;
#pragma unroll
                for (int bj = 0; bj < 2; ++bj)
#pragma unroll
                    for (int n = 0; n < 2; ++n) __builtin_nontemporal_store(acc[ai][bj][m][n] * rstd * g4[bj][n], (f32x4*)(orow + bj * 128 + n * 16));
            }
        __syncthreads();
    }
};

template <int NST, class F>
DI void small_gemm_tile(const u16* __restrict__ A, int lda, const u16* __restrict__ Bt, int ldb, int row0, int col0, unsigned char* lds, F&& epi) {
    const int tid = tidx(), lane = tid & 63, wid = __builtin_amdgcn_readfirstlane(tid >> 6), fr = lane & 15, fq = lane >> 4;
    const int koff = wid * (NST * 32) + fq * (NST * 8);
    bf16x8 af[4][NST], bfv[4][NST];
#pragma unroll
    for (int t = 0; t < 4; ++t)
#pragma unroll
        for (int j = 0; j < NST; ++j) {
            af[t][j] = *(const bf16x8*)(A + (size_t)(row0 + t * 16 + fr) * lda + koff + 8 * j);
            bfv[t][j] = *(const bf16x8*)(Bt + (size_t)(col0 + t * 16 + fr) * ldb + koff + 8 * j);
        }
    f32x4 acc[4][4];
#pragma unroll
    for (int m = 0; m < 4; ++m)
#pragma unroll
        for (int n = 0; n < 4; ++n) acc[m][n] = (f32x4){0.f, 0.f, 0.f, 0.f};
#pragma unroll
    for (int j = 0; j < NST; ++j)
#pragma unroll
        for (int m = 0; m < 4; ++m)
#pragma unroll
            for (int n = 0; n < 4; ++n) acc[m][n] = MFMA16(bfv[n][j], af[m][j], acc[m][n]);
    f32x4* Pw = (f32x4*)lds;
#pragma unroll
    for (int m = 0; m < 4; ++m)
#pragma unroll
        for (int n = 0; n < 4; ++n) Pw[(wid * 64 + m * 16 + fr) * 16 + ((n * 4 + fq) ^ fr)] = acc[m][n];
    __syncthreads();
    { const int row = tid >> 3;
#pragma unroll
      for (int h = 0; h < 2; ++h) {
          const int slot = (tid & 7) * 2 + h;
          f32x4 v = {0.f, 0.f, 0.f, 0.f};
#pragma unroll
          for (int w = 0; w < 8; ++w) v += Pw[(w * 64 + row) * 16 + (slot ^ (row & 15))];
          epi(row0 + row, col0 + slot * 4, v);
      } }
    __syncthreads();
}

DI void proj_store4(unsigned char* ws, int row, int col, f32x4 v) {
    const int type = col >> 9, cc = col & 511; const size_t o = (size_t)row * 512 + cc;
    if (type == 3) {
        const f32x4 lb = *(const f32x4*)((const float*)(ws + OFF_LB) + cc);
        f32x4 lf;
#pragma unroll
        for (int j = 0; j < 4; ++j) { const float x = fminf(fmaxf(v[j], -30.f), 30.f); const float e = __expf(-x), sg = 1.0f / (1.0f + e); lf[j] = __logf(lb[j] + (1.0f - lb[j]) * sg); }
        *(h16x4*)((_Float16*)(ws + OFF_LF) + o) = __builtin_convertvector(lf, h16x4);
    } else {
        if (type == 1 || type == 5) {
#pragma unroll
            for (int j = 0; j < 4; ++j) v[j] = siluf_(v[j]);
        }
        u16* O = (u16*)(ws + (type == 0 ? OFF_U : type == 1 ? OFF_SZS : type == 2 ? OFF_Q : type == 4 ? OFF_V : OFF_SZH));
        uint2 w; w.x = pk2(v[0], v[1]); w.y = pk2(v[2], v[3]); *(uint2*)(O + o) = w;
    }
}

DI void s5_pass1(const Params& P) {
    unsigned char* ws = P.ws;
    const int tid = tidx(), lane = tid & 63, wid = tid >> 6, gw = blockIdx.x * 8 + wid, nw = gridDim.x * 8;
    const int n = lane & 31, h = lane >> 5;
    const u16* U = (const u16*)(ws + OFF_U); const u16* BBR = (const u16*)(ws + OFF_BBR); const u16* BBI = (const u16*)(ws + OFF_BBI);
    const float2* APOW = (const float2*)(ws + OFF_APOW); float2* HEND = (float2*)(ws + OFF_HEND);
    const int gh = gw & 63, g = gh >> 1, half = gh & 1, p = half * 32 + n;
    const bf16x8 bre = *(const bf16x8*)(BBR + (size_t)(g * 64 + p) * 16 + 8 * h), bim = *(const bf16x8*)(BBI + (size_t)(g * 64 + p) * 16 + 8 * h);
    const float2* ap = APOW + (size_t)(g * 64 + p) * 65;
    float2 w[16];
#pragma unroll
    for (int i = 0; i < 16; ++i) w[i] = ap[31 - ((i & 3) + 8 * (i >> 2) + 4 * h)];
    const float2 a32 = ap[32];
    const int step = nw >> 6;
    int bc = gw >> 6;
    const u16* ub = U + (size_t)n * 512 + g * 16 + 8 * h;
    bf16x8 a0, a1;
    if (bc < 256) { const int tok0 = (bc >> 5) * 2048 + (bc & 31) * 64; a0 = *(const bf16x8*)(ub + (size_t)tok0 * 512); a1 = *(const bf16x8*)(ub + (size_t)(tok0 + 32) * 512); }
    for (; bc < 256; bc += step) {
        const int bn = (bc + step < 256) ? bc + step : bc;
        const int tokn = (bn >> 5) * 2048 + (bn & 31) * 64;
        const bf16x8 n0 = *(const bf16x8*)(ub + (size_t)tokn * 512), n1 = *(const bf16x8*)(ub + (size_t)(tokn + 32) * 512);
        f32x16 z; for (int i = 0; i < 16; ++i) z[i] = 0.f;
        const f32x16 cr0 = MFMA32(a0, bre, z), ci0 = MFMA32(a0, bim, z), cr1 = MFMA32(a1, bre, z), ci1 = MFMA32(a1, bim, z);
        float e0r = 0.f, e0i = 0.f, e1r = 0.f, e1i = 0.f;
#pragma unroll
        for (int i = 0; i < 16; ++i) {
            e1r += w[i].x * cr1[i] - w[i].y * ci1[i]; e1i += w[i].x * ci1[i] + w[i].y * cr1[i];
            e0r += w[i].x * cr0[i] - w[i].y * ci0[i]; e0i += w[i].x * ci0[i] + w[i].y * cr0[i];
        }
        float tr = e1r + a32.x * e0r - a32.y * e0i, ti = e1i + a32.x * e0i + a32.y * e0r;
        tr += __shfl_xor(tr, 32); ti += __shfl_xor(ti, 32);
        if (h == 0) HEND[(size_t)bc * 2048 + g * 64 + p] = make_float2(tr, ti);
        a0 = n0; a1 = n1;
    }
}

DI void s5_sample(const Params& P, unsigned char* lds) {
    unsigned char* ws = P.ws;
    const int tid = tidx(), lane = tid & 63, wid = tid >> 6, gw = blockIdx.x * 8 + wid, nw = gridDim.x * 8;
    float* Hw = (float*)lds + wid * 512;
    const u16* U = (const u16*)(ws + OFF_U); const u16* BBR = (const u16*)(ws + OFF_BBR); const u16* BBI = (const u16*)(ws + OFF_BBI);
    const float2* APOW = (const float2*)(ws + OFF_APOW); u16* G = (u16*)(ws + OFF_G);
    const int c = lane & 15, qd = lane >> 4, g = gw & 31, p = lane, step = nw >> 5;
    const float2 A = APOW[(size_t)(g * 64 + p) * 65 + 1];
    const u32x4 br0 = *(const u32x4*)(BBR + (size_t)(g * 64 + p) * 16), br1 = *(const u32x4*)(BBR + (size_t)(g * 64 + p) * 16 + 8);
    const u32x4 bi0 = *(const u32x4*)(BBI + (size_t)(g * 64 + p) * 16), bi1 = *(const u32x4*)(BBI + (size_t)(g * 64 + p) * 16 + 8);
    f32x4 crv[4], civ[4];
    { const float* cre = P.in[12] + ((size_t)g * 16 + c) * 64 + qd * 16; const float* cim = P.in[13] + ((size_t)g * 16 + c) * 64 + qd * 16;
#pragma unroll
      for (int i = 0; i < 4; ++i) { crv[i] = *(const f32x4*)(cre + 4 * i); civ[i] = *(const f32x4*)(cim + 4 * i); } }
    const float dd = P.in[14][g * 16 + c];
    int bs = gw >> 5;
    float chr = 0.f, chi = 0.f; u32x4 cu[8]; unsigned cud[4];
    if (bs < 128) {
        chr = P.in[2][(size_t)(bs * 32 + g) * 64 + p]; chi = P.in[3][(size_t)(bs * 32 + g) * 64 + p];
#pragma unroll
        for (int t = 0; t < 4; ++t) { const u16* ur = U + (size_t)(NP + bs * 4 + t) * 512 + g * 16; cu[2 * t] = *(const u32x4*)ur; cu[2 * t + 1] = *(const u32x4*)(ur + 8); cud[t] = ur[c]; }
    }
    for (; bs < 128; bs += step) {
        const int nb = (bs + step < 128) ? bs + step : bs;
        const float nhr = P.in[2][(size_t)(nb * 32 + g) * 64 + p], nhi = P.in[3][(size_t)(nb * 32 + g) * 64 + p];
        u32x4 nu[8]; unsigned nud[4];
#pragma unroll
        for (int t = 0; t < 4; ++t) { const u16* ur = U + (size_t)(NP + nb * 4 + t) * 512 + g * 16; nu[2 * t] = *(const u32x4*)ur; nu[2 * t + 1] = *(const u32x4*)(ur + 8); nud[t] = ur[c]; }
        float hr = chr, hi = chi;
#pragma unroll
        for (int t = 0; t < 4; ++t) {
            const u32x4 u0 = cu[2 * t], u1 = cu[2 * t + 1];
            float bur = 0.f, bui = 0.f;
#pragma unroll
            for (int k = 0; k < 8; ++k) {
                const unsigned uw = (k < 4) ? u0[k & 3] : u1[k & 3];
                const unsigned rw = (k < 4) ? br0[k & 3] : br1[k & 3];
                const unsigned iw = (k < 4) ? bi0[k & 3] : bi1[k & 3];
                const float ul = __uint_as_float(uw << 16), uh = __uint_as_float(uw & 0xffff0000u);
                bur += __uint_as_float(rw << 16) * ul + __uint_as_float(rw & 0xffff0000u) * uh;
                bui += __uint_as_float(iw << 16) * ul + __uint_as_float(iw & 0xffff0000u) * uh;
            }
            const float nr = A.x * hr - A.y * hi + bur, ni = A.x * hi + A.y * hr + bui;
            hr = nr; hi = ni;
            Hw[t * 128 + p] = hr; Hw[t * 128 + 64 + p] = hi;
        }
        P.out[O_SRE + (size_t)(bs * 32 + g) * 64 + p] = hr; P.out[O_SIM + (size_t)(bs * 32 + g) * 64 + p] = hi;
        wave_lds_sync();
#pragma unroll
        for (int t = 0; t < 4; ++t) {
            float a = 0.f;
#pragma unroll
            for (int i = 0; i < 16; ++i) a += crv[i >> 2][i & 3] * Hw[t * 128 + qd * 16 + i] - civ[i >> 2][i & 3] * Hw[t * 128 + 64 + qd * 16 + i];
            a += __shfl_xor(a, 16); a += __shfl_xor(a, 32);
            const size_t tok = (size_t)(NP + bs * 4 + t);
            const float y = a + dd * __uint_as_float(cud[t] << 16);
            if (qd == 0) G[tok * 512 + g * 16 + c] = f2bf(geluf_(y));
        }
        wave_lds_sync();
        chr = nhr; chi = nhi;
#pragma unroll
        for (int i = 0; i < 8; ++i) cu[i] = nu[i];
#pragma unroll
        for (int t = 0; t < 4; ++t) cud[t] = nud[t];
    }
}

struct HCols { float lf[16]; unsigned vq[16]; };
template <bool PASS2>
DI void hgrn_load_cols(const Params& P, int unit, HCols& r) {
    const unsigned char* ws = P.ws;
    const int col = tidx() & 127, segu = __builtin_amdgcn_readfirstlane((int)(tidx() >> 7));
    const int b = unit >> 7, hh = (unit >> 5) & 3, chunk = unit & 31;
    const size_t rb = (size_t)(b * 2048 + chunk * 64 + segu * 16) * 512 + hh * 128;
    const _Float16* lfp = (const _Float16*)(ws + OFF_LF) + rb; const u16* vp = (const u16*)(ws + OFF_V) + rb; const u16* qp = (const u16*)(ws + OFF_Q) + rb;
#pragma unroll
    for (int i = 0; i < 16; ++i) { r.lf[i] = (float)lfp[(size_t)i * 512 + col]; const unsigned v = vp[(size_t)i * 512 + col]; const unsigned q = PASS2 ? (unsigned)qp[(size_t)i * 512 + col] : 0u; r.vq[i] = v | (q << 16); }
}
template <bool PASS2>
DI void hgrn_unit(const Params& P, unsigned char* lds, int unit, const HCols& cur, int next_unit, HCols& nxt) {
    unsigned char* ws = P.ws;
    const int tid = tidx(), lane = tid & 63, wid = __builtin_amdgcn_readfirstlane(tid >> 6), fr = lane & 15, fq = lane >> 4;
    const int b = unit >> 7, hh = (unit >> 5) & 3, chunk = unit & 31;
    const int tokc = b * 2048 + chunk * 64;
    u16* Qt = (u16*)lds;
    u16* Kt = PASS2 ? (u16*)(lds + 17408) : (u16*)lds;
    u16* VT = (u16*)(lds + 34816);
    float* SEG = (float*)(lds + 53248);
    float* SS = (float*)(lds + 55296);
    const u16* SSTu = (const u16*)(ws + OFF_HB) + (size_t)unit * 16384;
    const int tt = wid & 3, vh = wid >> 2;
    bf16x8 asf[4][4]; f32x4 g4e[4]; uint2 ze[4];
    if (PASS2) {
#pragma unroll
        for (int vl = 0; vl < 4; ++vl) { const int v0 = hh * 128 + (vh * 4 + vl) * 16 + 4 * fq; g4e[vl] = *(const f32x4*)(P.in[18] + v0); ze[vl] = *(const uint2*)((const u16*)(ws + OFF_SZH) + (size_t)(tokc + tt * 16 + fr) * 512 + v0); }
#pragma unroll
        for (int vl = 0; vl < 4; ++vl)
#pragma unroll
            for (int ks = 0; ks < 4; ++ks) asf[vl][ks] = *(const bf16x8*)((SSTu + (size_t)(vh * 4 + vl) * 2048 + ks * 32) + (fr * 128 + fq * 8));
    }
    {
        const int col = tid & 127, seg = tid >> 7;
        float c[16], kf[16]; u16 vv[16], qq[16];
#pragma unroll
        for (int i = 0; i < 16; ++i) { c[i] = cur.lf[i]; vv[i] = (u16)(cur.vq[i] & 0xffffu); qq[i] = (u16)(cur.vq[i] >> 16); }
#pragma unroll
        for (int i = 0; i < 16; ++i) kf[i] = 1.0f - __expf(c[i]);
#pragma unroll
        for (int i = 1; i < 16; ++i) c[i] += c[i - 1];
        SEG[seg * 128 + col] = c[15];
        __syncthreads();
        float pre = 0.f, tot = 0.f;
#pragma unroll
        for (int s = 0; s < 4; ++s) { const float v = SEG[s * 128 + col]; tot += v; if (s < seg) pre += v; }
        u32x4 v0, v1;
        v0.x = (unsigned)vv[0] | ((unsigned)vv[1] << 16); v0.y = (unsigned)vv[2] | ((unsigned)vv[3] << 16); v0.z = (unsigned)vv[4] | ((unsigned)vv[5] << 16); v0.w = (unsigned)vv[6] | ((unsigned)vv[7] << 16);
        v1.x = (unsigned)vv[8] | ((unsigned)vv[9] << 16); v1.y = (unsigned)vv[10] | ((unsigned)vv[11] << 16); v1.z = (unsigned)vv[12] | ((unsigned)vv[13] << 16); v1.w = (unsigned)vv[14] | ((unsigned)vv[15] << 16);
        *(u32x4*)(VT + col * 72 + seg * 16) = v0; *(u32x4*)(VT + col * 72 + seg * 16 + 8) = v1;
        if (PASS2) {
#pragma unroll
            for (int i = 0; i < 16; ++i) {
                const float bb = pre + c[i];
                Qt[(seg * 16 + i) * 136 + col] = f2bf(bf2f(qq[i]) * __expf(bb));
                Kt[(seg * 16 + i) * 136 + col] = f2bf(kf[i] * __expf(-bb));
            }
        } else {
            float kh[16];
#pragma unroll
            for (int i = 0; i < 16; ++i) kh[i] = kf[i] * __expf(tot - (pre + c[i]));
            u32x4 k0, k1;
            k0.x = pk2(kh[0], kh[1]); k0.y = pk2(kh[2], kh[3]); k0.z = pk2(kh[4], kh[5]); k0.w = pk2(kh[6], kh[7]);
            k1.x = pk2(kh[8], kh[9]); k1.y = pk2(kh[10], kh[11]); k1.z = pk2(kh[12], kh[13]); k1.w = pk2(kh[14], kh[15]);
            *(u32x4*)(Kt + col * 72 + seg * 16) = k0; *(u32x4*)(Kt + col * 72 + seg * 16 + 8) = k1;
            if (seg == 0) ((float*)(ws + OFF_DEC))[(size_t)unit * 128 + col] = __expf(tot);
        }
        __syncthreads();
    }
    hgrn_load_cols<PASS2>(P, next_unit, nxt);
    if (!PASS2) {
        _Float16* SLOC = (_Float16*)(P.out + O_Y) + (size_t)unit * 16384;
        const int kt = wid;
        const bf16x8 a0 = *(const bf16x8*)(Kt + (kt * 16 + fr) * 72 + fq * 8), a1 = *(const bf16x8*)(Kt + (kt * 16 + fr) * 72 + 32 + fq * 8);
#pragma unroll
        for (int vt = 0; vt < 8; ++vt) {
            f32x4 acc = {0.f, 0.f, 0.f, 0.f};
            const bf16x8 b0 = *(const bf16x8*)(VT + (vt * 16 + fr) * 72 + fq * 8), b1 = *(const bf16x8*)(VT + (vt * 16 + fr) * 72 + 32 + fq * 8);
            acc = MFMA16(a0, b0, acc); acc = MFMA16(a1, b1, acc);
            *(h16x4*)(SLOC + (size_t)(vt * 16 + fr) * 128 + kt * 16 + 4 * fq) = __builtin_convertvector(acc, h16x4);
        }
    } else {
        bf16x8 bq[4];
#pragma unroll
        for (int ks = 0; ks < 4; ++ks) bq[ks] = *(const bf16x8*)(Qt + (tt * 16 + fr) * 136 + ks * 32 + fq * 8);
        float pv[4][4];
#pragma unroll
        for (int st = 0; st < 4; ++st) {
            f32x4 pa = {0.f, 0.f, 0.f, 0.f};
#pragma unroll
            for (int ks = 0; ks < 4; ++ks) { const bf16x8 ak = *(const bf16x8*)(Kt + (st * 16 + fr) * 136 + ks * 32 + fq * 8); pa = MFMA16(ak, bq[ks], pa); }
#pragma unroll
            for (int j = 0; j < 4; ++j) pv[st][j] = ((st * 16 + 4 * fq + j) <= (tt * 16 + fr)) ? pa[j] : 0.f;
        }
        bf16x8 pf[2];
#pragma unroll
        for (int k2 = 0; k2 < 2; ++k2) {
            u32x4 w; w.x = pk2(pv[2 * k2][0], pv[2 * k2][1]); w.y = pk2(pv[2 * k2][2], pv[2 * k2][3]); w.z = pk2(pv[2 * k2 + 1][0], pv[2 * k2 + 1][1]); w.w = pk2(pv[2 * k2 + 1][2], pv[2 * k2 + 1][3]);
            pf[k2] = __builtin_bit_cast(bf16x8, w);
        }
        f32x4 oacc[4]; float ssq = 0.f;
#pragma unroll
        for (int vl = 0; vl < 4; ++vl) {
            const int vt = vh * 4 + vl;
            f32x4 o = {0.f, 0.f, 0.f, 0.f};
#pragma unroll
            for (int k2 = 0; k2 < 2; ++k2) {
                const s16x4 lo = *(const s16x4*)(VT + (vt * 16 + fr) * 72 + 32 * k2 + 4 * fq), hi = *(const s16x4*)(VT + (vt * 16 + fr) * 72 + 32 * k2 + 16 + 4 * fq);
                const bf16x8 av = __builtin_shufflevector(lo, hi, 0, 1, 2, 3, 4, 5, 6, 7);
                o = MFMA16(av, pf[k2], o);
            }
#pragma unroll
            for (int ks = 0; ks < 4; ++ks) o = MFMA16(asf[vl][ks], bq[ks], o);
            oacc[vl] = o; ssq += o[0] * o[0] + o[1] * o[1] + o[2] * o[2] + o[3] * o[3];
        }
        ssq += __shfl_xor(ssq, 16); ssq += __shfl_xor(ssq, 32);
        if (fq == 0) SS[vh * 64 + tt * 16 + fr] = ssq;
        __syncthreads();
        const float rstd = rsqrtf((SS[tt * 16 + fr] + SS[64 + tt * 16 + fr]) * (1.0f / 128.0f) + EPSF);
        const size_t tok = (size_t)(tokc + tt * 16 + fr);
        u16* CAT = (u16*)(ws + OFF_CAT);
#pragma unroll
        for (int vl = 0; vl < 4; ++vl) {
            const int v0 = hh * 128 + (vh * 4 + vl) * 16 + 4 * fq;
            const f32x4 g4 = g4e[vl];
            const uint2 z = ze[vl];
            uint2 w;
            w.x = pk2(oacc[vl][0] * rstd * g4[0] * __uint_as_float(z.x << 16), oacc[vl][1] * rstd * g4[1] * __uint_as_float(z.x & 0xffff0000u));
            w.y = pk2(oacc[vl][2] * rstd * g4[2] * __uint_as_float(z.y << 16), oacc[vl][3] * rstd * g4[3] * __uint_as_float(z.y & 0xffff0000u));
            *(uint2*)(CAT + tok * 1024 + 512 + v0) = w;
        }
    }
    __syncthreads();
}

DI void hgrn_sample_load(const Params& P, int task, f32x4 (&s0v)[8]) {
    const int tid = tidx();
    const float* S0 = P.in[4] + (size_t)task * 16384 + (size_t)((tid >> 5) * 8) * 128 + 4 * (tid & 31);
#pragma unroll
    for (int i = 0; i < 8; ++i) s0v[i] = __builtin_nontemporal_load((const f32x4*)(S0 + (size_t)i * 128));
}
DI void hgrn_sample(const Params& P, unsigned char* lds, int task, const f32x4 (&s0v)[8], int next_task, f32x4 (&s0n)[8]) {
    unsigned char* ws = P.ws;
    const int tid = tidx(), lane = tid & 63, wid = tid >> 6;
    const int bs = task >> 2, hh = task & 3;
    float* QE = (float*)lds;
    float* KH = QE + 512;
    float* EB3 = KH + 512;
    float* VV = EB3 + 128;
    float* RED = VV + 512;
    float* RED2 = RED + 32;
    float* OP = RED2 + 32;
    const size_t tokb = (size_t)(NP + bs * 4);
    const float zfin = bf2f(((const u16*)(ws + OFF_SZH))[(tokb + (tid >> 7)) * 512 + hh * 128 + (tid & 127)]);
    const float gfin_ = P.in[18][hh * 128 + (tid & 127)];
    if (next_task != task) hgrn_sample_load(P, next_task, s0n);
    if (tid < 128) {
        const int k = tid; float lf[4], q[4], kk[4], bb[4];
#pragma unroll
        for (int t = 0; t < 4; ++t) { const size_t o = (tokb + t) * 512 + hh * 128 + k; lf[t] = (float)((const _Float16*)(ws + OFF_LF))[o]; q[t] = bf2f(((const u16*)(ws + OFF_Q))[o]); kk[t] = 1.0f - __expf(lf[t]); }
        bb[0] = lf[0]; bb[1] = bb[0] + lf[1]; bb[2] = bb[1] + lf[2]; bb[3] = bb[2] + lf[3];
#pragma unroll
        for (int t = 0; t < 4; ++t) { QE[t * 128 + k] = q[t] * __expf(bb[t]); KH[t * 128 + k] = kk[t] * __expf(bb[3] - bb[t]); }
        EB3[k] = __expf(bb[3]);
        int idx = 0;
#pragma unroll
        for (int t = 0; t < 4; ++t)
#pragma unroll
            for (int s = 0; s <= t; ++s) { float pr = q[t] * kk[s] * __expf(bb[t] - bb[s]); pr = wave_sum(pr); if (lane == 0) RED[wid * 16 + idx] = pr; ++idx; }
    } else if (tid < 256) {
        const int v = tid - 128;
#pragma unroll
        for (int s = 0; s < 4; ++s) VV[s * 128 + v] = bf2f(((const u16*)(ws + OFF_V))[(tokb + s) * 512 + hh * 128 + v]);
    }
    __syncthreads();
    {
        const int v4 = tid & 31, kg = tid >> 5;
        const float* S0 = P.in[4] + (size_t)(bs * 4 + hh) * 16384; float* SN = P.out + O_SHG + (size_t)(bs * 4 + hh) * 16384;
        f32x4 op[4]; for (int t = 0; t < 4; ++t) op[t] = (f32x4){0.f, 0.f, 0.f, 0.f};
        f32x4 vs[4]; for (int s = 0; s < 4; ++s) vs[s] = *(const f32x4*)(VV + s * 128 + 4 * v4);
#pragma unroll
        for (int i = 0; i < 8; ++i) {
            const int k = kg * 8 + i;
            const f32x4 s4 = s0v[i];
            f32x4 sn = s4 * EB3[k];
#pragma unroll
            for (int t = 0; t < 4; ++t) { op[t] += s4 * QE[t * 128 + k]; sn += vs[t] * KH[t * 128 + k]; }
            __builtin_nontemporal_store(sn, (f32x4*)(SN + (size_t)k * 128 + 4 * v4));
        }
#pragma unroll
        for (int t = 0; t < 4; ++t) *(f32x4*)(OP + (kg * 4 + t) * 128 + 4 * v4) = op[t];
    }
    __syncthreads();
    {
        const int t = tid >> 7, v = tid & 127;
        float o = 0.f;
#pragma unroll
        for (int kg = 0; kg < 16; ++kg) o += OP[(kg * 4 + t) * 128 + v];
        const int tb = (t * (t + 1)) >> 1;
        for (int s = 0; s <= t; ++s) o += (RED[tb + s] + RED[16 + tb + s]) * VV[s * 128 + v];
        const float ss = wave_sum(o * o);
        if (lane == 0) RED2[wid] = ss;
        __syncthreads();
        const float rstd = rsqrtf((RED2[2 * t] + RED2[2 * t + 1]) * (1.0f / 128.0f) + EPSF);
        const size_t tok = tokb + t;
        ((u16*)(ws + OFF_CAT))[tok * 1024 + 512 + hh * 128 + v] = f2bf(o * rstd * gfin_ * zfin);
    }
    __syncthreads();
}

DI void phase_scan(const Params& P) {
    unsigned char* ws = P.ws;
    const int gt = blockIdx.x * NTHR + tidx(), ngt = gridDim.x * NTHR;
    { const _Float16* SLOC = (const _Float16*)(P.out + O_Y); const float* DEC = (const float*)(ws + OFF_DEC); u16* SST = (u16*)(ws + OFF_HB);
      for (int idx = gt; idx < 131072; idx += ngt) {
          const int bh = idx >> 12, rem = idx & 4095, v = rem >> 5, k4 = rem & 31;
          f32x4 S = {0.f, 0.f, 0.f, 0.f};
          for (int c0 = 0; c0 < 32; c0 += 8) {
              f32x4 sl[8], d[8];
#pragma unroll
              for (int c = 0; c < 8; ++c) { const size_t unit = (size_t)bh * 32 + c0 + c;
                  sl[c] = __builtin_convertvector(*(const h16x4*)(SLOC + (unit * 128 + v) * 128 + 4 * k4), f32x4); d[c] = *(const f32x4*)(DEC + unit * 128 + 4 * k4); }
#pragma unroll
              for (int c = 0; c < 8; ++c) { const size_t unit = (size_t)bh * 32 + c0 + c;
                  uint2 w; w.x = pk2(S[0], S[1]); w.y = pk2(S[2], S[3]);
                  *(uint2*)(SST + (unit * 128 + v) * 128 + 4 * k4) = w;
                  S = d[c] * S + sl[c]; }
          }
#pragma unroll
          for (int j = 0; j < 4; ++j) P.out[O_PHG + ((size_t)bh * 128 + 4 * k4 + j) * 128 + v] = S[j];
      } }
}

template <bool FUSE>
DI void s5_pass2(const Params& P, unsigned char* lds) {
    unsigned char* ws = P.ws;
    const int tid = tidx(), lane = tid & 63, wid = tid >> 6, gw = blockIdx.x * 8 + wid, nw = gridDim.x * 8, fr = lane & 15, fq = lane >> 4;
    float* BUw = (float*)(lds + wid * 12800);
    unsigned char* Hw = lds + wid * 12800 + 8448;
    const u16* U = (const u16*)(ws + OFF_U); const u16* BBR = (const u16*)(ws + OFF_BBR); const u16* BBI = (const u16*)(ws + OFF_BBI); const u16* CMT = (const u16*)(ws + OFF_CMT);
    const float2* APOW = (const float2*)(ws + OFF_APOW); u16* G = (u16*)(ws + OFF_G);
    const bf16x8 zero8 = {0, 0, 0, 0, 0, 0, 0, 0};
    const float2* HEND = (const float2*)(ws + OFF_HEND);
    const int sidx = blockIdx.x * NTHR + tid, sbh = sidx >> 12, sv = (sidx & 4095) >> 5, sk4 = sidx & 31;
    const _Float16* slp = (const _Float16*)(P.out + O_Y) + ((size_t)sbh * 32 * 128 + sv) * 128 + 4 * sk4;
    const float* dcp = (const float*)(ws + OFF_DEC) + (size_t)sbh * 32 * 128 + 4 * sk4;
    u16* stp = (u16*)(ws + OFF_HB) + ((size_t)sbh * 32 * 128 + sv) * 128 + 4 * sk4;
    f32x4 S = {0.f, 0.f, 0.f, 0.f};
    h16x4 csl[2], nsl[2]; f32x4 cd[2], nd[2];
    if (FUSE) {
#pragma unroll
        for (int c = 0; c < 2; ++c) { csl[c] = *(const h16x4*)(slp + (size_t)c * 16384); cd[c] = *(const f32x4*)(dcp + (size_t)c * 128); }
    }
    for (int T = gw; T < 2048; T += nw) {
        const bool scan_here = FUSE && (T == gw);
        const int g = T & 31, br = T >> 5, b = br >> 3, run = br & 7, p = lane;
        const float2 A = APOW[(size_t)(g * 64 + p) * 65 + 1];
        const float2 a64 = APOW[(size_t)(g * 64 + p) * 65 + 64];
        float hr = 0.f, hi = 0.f;
        { float2 e[28];
#pragma unroll
          for (int c2 = 0; c2 < 28; ++c2) if (c2 < 4 * run) e[c2] = HEND[(size_t)(b * 32 + c2) * 2048 + g * 64 + p];
#pragma unroll
          for (int c2 = 0; c2 < 28; ++c2) if (c2 < 4 * run) { const float nr = a64.x * hr - a64.y * hi + e[c2].x, ni = a64.x * hi + a64.y * hr + e[c2].y; hr = nr; hi = ni; } }
        bf16x8 bfr[8], cfr[4];
#pragma unroll
        for (int nt = 0; nt < 8; ++nt) { const u16* src = ((nt & 1) ? BBI : BBR) + (size_t)(g * 64 + (nt >> 1) * 16 + fr) * 16 + 8 * (fq & 1); bfr[nt] = (fq < 2) ? *(const bf16x8*)src : zero8; }
#pragma unroll
        for (int ks = 0; ks < 4; ++ks) cfr[ks] = *(const bf16x8*)(CMT + (size_t)(g * 16 + fr) * 128 + ks * 32 + fq * 8);
        bf16x8 dfr;
        { const short dbits = (short)f2bf(P.in[14][g * 16 + fr]);
#pragma unroll
          for (int j = 0; j < 8; ++j) dfr[j] = (fq < 2 && 8 * fq + j == fr) ? dbits : (short)0; }
        const int cre_col = (p >> 4) * 32 + (p & 15);
        const int tok0 = b * 2048 + run * 256;
        const u16* up = U + (size_t)(tok0 + fr) * 512 + g * 16 + 8 * (fq & 1);
        bf16x8 a = (fq < 2) ? *(const bf16x8*)up : zero8;
        bf16x8 a1 = (fq < 2) ? *(const bf16x8*)(up + (size_t)16 * 512) : zero8;
#define S5_BU(AOP) do { _Pragma("unroll") for (int nt = 0; nt < 8; ++nt) { f32x4 c_ = {0.f, 0.f, 0.f, 0.f}; c_ = MFMA16((AOP), bfr[nt], c_); \
            _Pragma("unroll") for (int j = 0; j < 4; ++j) BUw[(4 * fq + j) * 132 + nt * 16 + fr] = c_[j]; } } while (0)
        S5_BU(a);
        wave_lds_sync();
        for (int tt = 0; tt < 16; ++tt) {
            const int tokb = tok0 + tt * 16;
            const bf16x8 a2 = (fq < 2) ? *(const bf16x8*)(up + (size_t)((tt < 14 ? tt + 2 : 15) * 16) * 512) : zero8;
            if (scan_here) {
                const int cn = tt < 15 ? 2 * tt + 2 : 30;
#pragma unroll
                for (int c = 0; c < 2; ++c) { nsl[c] = *(const h16x4*)(slp + (size_t)(cn + c) * 16384); nd[c] = *(const f32x4*)(dcp + (size_t)(cn + c) * 128); }
            }
#pragma unroll
            for (int t = 0; t < 16; ++t) {
                const float bur = BUw[t * 132 + cre_col], bui = BUw[t * 132 + cre_col + 16];
                const float nr = A.x * hr - A.y * hi + bur, ni = A.x * hi + A.y * hr + bui;
                hr = nr; hi = ni;
                *(unsigned*)(Hw + t * 272 + 4 * p) = pk2(hr, hi);
            }
            if (scan_here) {
#pragma unroll
                for (int c = 0; c < 2; ++c) {
                    uint2 w; w.x = pk2(S[0], S[1]); w.y = pk2(S[2], S[3]);
                    *(uint2*)(stp + (size_t)(2 * tt + c) * 16384) = w;
                    S = cd[c] * S + __builtin_convertvector(csl[c], f32x4);
                    csl[c] = nsl[c]; cd[c] = nd[c];
                }
            }
            wave_lds_sync();
            f32x4 y = {0.f, 0.f, 0.f, 0.f};
            y = MFMA16(a, dfr, y);
#pragma unroll
            for (int ks = 0; ks < 4; ++ks) { const bf16x8 af = *(const bf16x8*)(Hw + fr * 272 + (ks * 32 + fq * 8) * 2); y = MFMA16(af, cfr[ks], y); }
            if (tt < 15) S5_BU(a1);
#pragma unroll
            for (int j = 0; j < 4; ++j) {
                const size_t tok = (size_t)(tokb + 4 * fq + j);
                G[tok * 512 + g * 16 + fr] = f2bf(geluf_(y[j]));
            }
            wave_lds_sync();
            a = a1; a1 = a2;
        }
#undef S5_BU
        if (run == 7) { P.out[O_PRE + (size_t)b * 2048 + g * 64 + p] = hr; P.out[O_PIM + (size_t)b * 2048 + g * 64 + p] = hi; }
        if (scan_here) {
#pragma unroll
            for (int j = 0; j < 4; ++j) P.out[O_PHG + ((size_t)sbh * 128 + 4 * sk4 + j) * 128 + sv] = S[j];
        }
    }
}

DI void phase_final_norm(const Params& P) {
    const float* ssq = (const float*)(P.ws + OFF_SSQ); const float* gf = P.in[20];
    const int gt = blockIdx.x * NTHR + tidx(), ngt = gridDim.x * NTHR;
    for (int i = gt; i < (NTOK - NP) * 256; i += ngt) {
        const int r = NP + (i >> 8), c4 = (i & 255) * 4;
        const float rstd = rsqrtf(ssq[r] * (1.0f / 1024.0f) + EPSF);
        f32x4 v = *(f32x4*)(P.out + (size_t)r * 1024 + c4);
        const f32x4 g4 = *(const f32x4*)(gf + c4);
        v = v * rstd * g4;
        *(f32x4*)(P.out + (size_t)r * 1024 + c4) = v;
    }
}

__global__ __launch_bounds__(512, 2) void fwd_megakernel(Params P) {
    extern __shared__ __attribute__((aligned(16))) unsigned char shm[];
    cg::grid_group grid = cg::this_grid();
    unsigned char* ws = P.ws;
    if (ws == nullptr) grid.sync();
    if (threadIdx.x == 0) *(uint4*)(shm + 131072) = make_uint4(0u, 0u, 0u, 0u);
    __syncthreads();
    const XcdBarrier xb = xcd_barrier_post((unsigned*)(ws + OFF_BAR), (volatile LAS unsigned*)(shm + 131072));
    pg8::StaticOrder S;
    phase_prep(P, shm);
    xcd_barrier(xb);
    { pg8::Gemm g; g.A = (const pg8::bf16_t*)(ws + OFF_HB); g.Bt = (const pg8::bf16_t*)(ws + OFF_WIN); g.M = NP; g.N = 3072; g.K = 1024;
      S.init(g.M, g.N, (int)gridDim.x, (int)blockIdx.x); EpiProj E; E.ws = ws;
      pg8::gemm_phase<EpiProj, pg8::StaticOrder, false>((PG8_LAS unsigned char*)shm, g, S, E, nullptr);
      for (int t = blockIdx.x; t < 384; t += gridDim.x) {
          const int rt = t / 48, ct = t - rt * 48;
          small_gemm_tile<4>((const u16*)(ws + OFF_HB), 1024, (const u16*)(ws + OFF_WIN), 1024, NP + rt * 64, ct * 64, shm, [&](int row, int col, f32x4 v) { proj_store4(ws, row, col, v); });
      } }
    xcd_barrier(xb);
    { HCols cur, nxt; hgrn_load_cols<false>(P, blockIdx.x, cur);
      s5_pass1(P);
      for (int unit = blockIdx.x; unit < 1024; unit += gridDim.x) {
          const int nu = unit + (int)gridDim.x;
          hgrn_unit<false>(P, shm, unit, cur, nu < 1024 ? nu : unit, nxt); cur = nxt; } }
    if (blockIdx.x < 512) {
        f32x4 s0a[8], s0b[8]; hgrn_sample_load(P, blockIdx.x, s0a);
        for (int task = blockIdx.x; task < 512; task += gridDim.x) {
            const int nt = task + (int)gridDim.x;
            hgrn_sample(P, shm, task, s0a, nt < 512 ? nt : task, s0b);
#pragma unroll
            for (int i = 0; i < 8; ++i) s0a[i] = s0b[i];
        }
    }
    s5_sample(P, shm);
    xcd_barrier(xb);
    if (gridDim.x == 256) s5_pass2<true>(P, shm);
    else { phase_scan(P); s5_pass2<false>(P, shm); }
    xcd_barrier(xb);
    { pg8::Gemm g; g.A = (const pg8::bf16_t*)(ws + OFF_G); g.Bt = (const pg8::bf16_t*)(ws + OFF_WGLU); g.M = NP; g.N = 512; g.K = 512;
      S.init(g.M, g.N, (int)gridDim.x, (int)blockIdx.x); EpiGlu E; E.ws = ws; E.bglu = P.in[16];
      pg8::gemm_phase<EpiGlu, pg8::StaticOrder, false>((PG8_LAS unsigned char*)shm, g, S, E, nullptr);
      __syncthreads();
      if (gridDim.x == 256) {
          const int c = (int)blockIdx.x;
          const int u0 = c < 128 ? c * 2 : 256 + (c - 128) * 6, nu = c < 128 ? 2 : 6;
          HCols cur, nxt; hgrn_load_cols<true>(P, u0, cur);
          for (int i = 0; i < nu; ++i) { hgrn_unit<true>(P, shm, u0 + i, cur, i + 1 < nu ? u0 + i + 1 : u0 + i, nxt); cur = nxt; }
      } else {
          HCols cur, nxt; if (blockIdx.x < 1024) hgrn_load_cols<true>(P, blockIdx.x, cur);
          for (int unit = blockIdx.x; unit < 1024; unit += gridDim.x) { const int nu2 = unit + (int)gridDim.x; hgrn_unit<true>(P, shm, unit, cur, nu2 < 1024 ? nu2 : unit, nxt); cur = nxt; } }
      const int nbusy = 128 < (int)gridDim.x ? 128 : 0;
      for (int t = (int)blockIdx.x - nbusy; t >= 0 && t < 64; t += (int)gridDim.x - nbusy) {
          const float* bglu = P.in[16];
          small_gemm_tile<2>((const u16*)(ws + OFF_G), 512, (const u16*)(ws + OFF_WGLU), 512, NP + (t >> 3) * 64, (t & 7) * 64, shm, [&](int row, int col, f32x4 v) {
              const size_t o = (size_t)row * 512 + col;
              const f32x4 b4 = *(const f32x4*)(bglu + col);
              const uint2 g2 = *(const uint2*)((const u16*)(ws + OFF_G) + o), z2 = *(const uint2*)((const u16*)(ws + OFF_SZS) + o);
              const float o0 = __uint_as_float(g2.x << 16) * sigmoidf_(v[0] + b4[0]) * __uint_as_float(z2.x << 16);
              const float o1 = __uint_as_float(g2.x & 0xffff0000u) * sigmoidf_(v[1] + b4[1]) * __uint_as_float(z2.x & 0xffff0000u);
              const float o2 = __uint_as_float(g2.y << 16) * sigmoidf_(v[2] + b4[2]) * __uint_as_float(z2.y << 16);
              const float o3 = __uint_as_float(g2.y & 0xffff0000u) * sigmoidf_(v[3] + b4[3]) * __uint_as_float(z2.y & 0xffff0000u);
              uint2 w; w.x = pk2(o0, o1); w.y = pk2(o2, o3);
              *(uint2*)((u16*)(ws + OFF_CAT) + (size_t)row * 1024 + col) = w; });
      } }
    xcd_barrier(xb);
    { pg8::Gemm g; g.A = (const pg8::bf16_t*)(ws + OFF_CAT); g.Bt = (const pg8::bf16_t*)(ws + OFF_WOUT); g.M = NP; g.N = 1024; g.K = 1024;
      PanelOrder PO; PO.c = (int)blockIdx.x;
      EpiOutNorm E; E.xp = P.in[0]; E.out = P.out; E.gfin = P.in[20]; E.xs = (float*)(ws + OFF_XS); E.cnt = (unsigned*)(ws + OFF_CNT);
      pg8::gemm_phase<EpiOutNorm, PanelOrder, false>((PG8_LAS unsigned char*)shm, g, PO, E, nullptr);
      float* ssq = (float*)(ws + OFF_SSQ); const float* xs = P.in[1]; float* out = P.out;
      for (int t = blockIdx.x; t < 128; t += gridDim.x) {
          small_gemm_tile<4>((const u16*)(ws + OFF_CAT), 1024, (const u16*)(ws + OFF_WOUT), 1024, NP + (t >> 4) * 64, (t & 15) * 64, shm, [&](int row, int col, f32x4 v) {
              const f32x4 r = v + *(const f32x4*)(xs + (size_t)(row - NP) * 1024 + col);
              *(f32x4*)(out + (size_t)row * 1024 + col) = r;
              float ss = r[0] * r[0] + r[1] * r[1] + r[2] * r[2] + r[3] * r[3];
              ss += __shfl_xor(ss, 1); ss += __shfl_xor(ss, 2); ss += __shfl_xor(ss, 4);
              if ((threadIdx.x & 7) == 0) atomicAdd(ssq + row, ss); });
      } }
    xcd_barrier(xb);
    phase_final_norm(P);
}

extern "C" void kernel_launch(void* const* d_in, const int* in_sizes, int n_in, void* d_out, int out_size, void* d_ws, size_t ws_size, hipStream_t stream) {
    static int grid_blocks = 0;
    if (!grid_blocks) {
        int dev = 0, cus = 0, per_cu = 0;
        hipGetDevice(&dev);
        hipDeviceGetAttribute(&cus, hipDeviceAttributeMultiprocessorCount, dev);
        hipFuncSetAttribute((const void*)fwd_megakernel, hipFuncAttributeMaxDynamicSharedMemorySize, LDS_BYTES);
        hipOccupancyMaxActiveBlocksPerMultiprocessor(&per_cu, (const void*)fwd_megakernel, NTHR, LDS_BYTES);
        if (per_cu < 1) per_cu = 1;
        if (per_cu > 1) per_cu = 1;
        grid_blocks = cus * per_cu;
        if (grid_blocks != 256) fprintf(stderr, "kernel_launch: built for a 256-CU device (one workgroup per CU); got %d\n", grid_blocks);
        if (ws_size < WS_END) fprintf(stderr, "kernel_launch: workspace too small: %zu < %zu\n", ws_size, (size_t)WS_END);
    }
    if (hipMemsetAsync((unsigned char*)d_ws + OFF_BAR, 0, ZERO_BYTES, stream) != hipSuccess) fprintf(stderr, "kernel_launch: memset of barrier words failed\n");
    Params p{};
    for (int i = 0; i < 21; ++i) p.in[i] = (const float*)d_in[i];
    p.out = (float*)d_out; p.ws = (unsigned char*)d_ws;
    void* args[] = {&p};
    hipError_t e = hipLaunchCooperativeKernel((void*)fwd_megakernel, dim3(grid_blocks), dim3(NTHR), args, LDS_BYTES, stream);
    if (e != hipSuccess) fprintf(stderr, "cooperative launch failed: %s (grid %d)\n", hipGetErrorString(e), grid_blocks);
}
```
